# Optimizing an MI355X kernel written in HIP

```python
import math
import jax, jax.numpy as jnp
from jax import lax
import numpy as np

D_MODEL = 1024
BATCH = 16
SEQ = 2048
DEPTH = 4

N_MIXERS = 3
PLE_DIM = 256
ROPE_THETA = 10000.0
NORM_EPS = 1e-6
POS_OFFSET_MAX = 4096

RET_HEADS = 4
RET_DK = D_MODEL // RET_HEADS
RET_DV = 2 * RET_DK
RET_CHUNK = 128

NSA_HEADS = 8
NSA_GROUPS = 2
NSA_DH = D_MODEL // NSA_HEADS
NSA_CMP_LEN = 32
NSA_CMP_STRIDE = 16
NSA_SEL_LEN = 64
NSA_TOP_N = 16
NSA_WINDOW = 512
NSA_CMP_HID = 256
NSA_SEL_Q_BLOCK = 16
NSA_WIN_Q_BLOCK = 128

S5_GROUP = 16
S5_GROUPS = D_MODEL // S5_GROUP
S5_STATE = 64

D_FF = 2816
N_EXPERTS = 8
TOP_K = 2
D_FF_EXPERT = 3584

kernel_name = "hybrid_retention_nsa_s5_moe_trunk"


def rms_norm(x, g):
    xf = x.astype(jnp.float32)
    y = xf * lax.rsqrt(jnp.mean(xf * xf, axis=-1, keepdims=True) + NORM_EPS)
    return (y * g.astype(jnp.float32)).astype(x.dtype)


def rope(x, pos):
    d = x.shape[-1]
    inv = ROPE_THETA ** (-jnp.arange(0, d, 2, dtype=jnp.float32) / d)
    ang = pos.astype(jnp.float32)[..., None] * inv
    cos = jnp.cos(ang)[..., None, :]
    sin = jnp.sin(ang)[..., None, :]
    xf = x.astype(jnp.float32)
    x1, x2 = xf[..., : d // 2], xf[..., d // 2:]
    return jnp.concatenate([x1 * cos - x2 * sin, x2 * cos + x1 * sin], axis=-1).astype(x.dtype)


def swiglu(h, w_gate_up, w_down):
    g, u = jnp.split(h @ w_gate_up, 2, axis=-1)
    return (jax.nn.silu(g) * u) @ w_down


def retention_mixer(xn, pos, w_in, gn, w_out):
    B, S, _ = xn.shape
    H, dk, dv, C = RET_HEADS, RET_DK, RET_DV, RET_CHUNK
    N = S // C
    q, k, v, g = jnp.split(xn @ w_in, [H * dk, 2 * H * dk, 2 * H * dk + H * dv], axis=-1)
    q = rope(q.reshape(B, S, H, dk), pos)
    k = rope(k.reshape(B, S, H, dk), pos) * (dk ** -0.5)
    v = v.reshape(B, S, H, dv)
    log_gamma = jnp.log1p(-jnp.exp2(-5.0 - jnp.arange(H, dtype=jnp.float32)))
    idx = jnp.arange(C, dtype=jnp.float32)
    diff = idx[:, None] - idx[None, :]
    d_mask = jnp.where(diff >= 0, jnp.exp(jnp.maximum(diff, 0.0) * log_gamma[:, None, None]), 0.0)
    q_decay = jnp.exp((idx + 1.0) * log_gamma[:, None])
    k_decay = jnp.exp((C - 1.0 - idx) * log_gamma[:, None])
    chunk_decay = jnp.exp(C * log_gamma)

    def chunks(t):
        return t.reshape(B, N, C, H, t.shape[-1]).transpose(1, 0, 3, 2, 4)

    def step(R, inp):
        qn, kn, vn = inp
        scores = jnp.einsum('bhid,bhjd->bhij', qn, kn) * d_mask
        intra = jnp.einsum('bhij,bhjv->bhiv', scores, vn)
        cross = jnp.einsum('bhid,bhdv->bhiv', qn, R) * q_decay[None, :, :, None]
        R_new = R * chunk_decay[None, :, None, None] + jnp.einsum(
            'bhjd,bhjv->bhdv', kn * k_decay[None, :, :, None], vn)
        return R_new, intra + cross

    R0 = jnp.zeros((B, H, dk, dv), jnp.float32)
    _, o = lax.scan(step, R0, (chunks(q), chunks(k), chunks(v)))
    o = o.transpose(1, 0, 3, 2, 4).reshape(B, S, H, dv)
    mu = jnp.mean(o, axis=-1, keepdims=True)
    var = jnp.mean(jnp.square(o - mu), axis=-1, keepdims=True)
    o = ((o - mu) * lax.rsqrt(var + NORM_EPS)).reshape(B, S, H * dv) * gn.astype(jnp.float32)
    return (o.astype(xn.dtype) * jax.nn.silu(g)) @ w_out


def nsa_mixer(xn, pos, w_in, q_norm, k_norm, cmp_pos, cmp_w1, cmp_w2, w_out):
    B, S, _ = xn.shape
    H, G, dh = NSA_HEADS, NSA_GROUPS, NSA_DH
    hg = H // G
    L, STR, SEL, WIN = NSA_CMP_LEN, NSA_CMP_STRIDE, NSA_SEL_LEN, NSA_WINDOW
    neg = jnp.finfo(jnp.float32).min
    scale = dh ** -0.5
    kvw = G * dh
    cuts = [int(c) for c in np.cumsum([H * dh, kvw, kvw, kvw, kvw, kvw, kvw])]
    q, kc, vc, ks, vs, kw, vw, gate = jnp.split(xn @ w_in, cuts, axis=-1)

    q = rope(rms_norm(q.reshape(B, S, H, dh), q_norm), pos).reshape(B, S, G, hg, dh)
    ks = rope(rms_norm(ks.reshape(B, S, G, dh), k_norm[1]), pos)
    kw = rope(rms_norm(kw.reshape(B, S, G, dh), k_norm[2]), pos)
    vs = vs.reshape(B, S, G, dh)
    vw = vw.reshape(B, S, G, dh)
    t_idx = jnp.arange(S)

    n_c = (S - L) // STR + 1
    blk = np.arange(n_c)[:, None] * STR + np.arange(L)[None, :]
    cmp_start = blk[:, 0]

    def compress(t, pos_emb, w1, w2):
        tb = t.reshape(B, S, G, dh)[:, blk] + pos_emb[None, None, :, None, :]
        tb = tb.transpose(0, 1, 3, 2, 4).reshape(B, n_c, G, L * dh)
        return jax.nn.gelu(tb @ w1) @ w2

    kc = compress(kc, cmp_pos[0], cmp_w1[0], cmp_w2[0])
    vc = compress(vc, cmp_pos[1], cmp_w1[1], cmp_w2[1])
    kc = rope(rms_norm(kc, k_norm[0]), pos[:, cmp_start])
    s_c = jnp.einsum('bsghd,bcgd->bghsc', q, kc).astype(jnp.float32) * scale
    valid_c = jnp.asarray(blk[:, -1])[None, :] <= t_idx[:, None]
    p_c = jax.nn.softmax(jnp.where(valid_c, s_c, neg), axis=-1)
    p_c = jnp.where(valid_c, p_c, 0.0)
    o_c = jnp.einsum('bghsc,bcgd->bsghd', p_c.astype(vc.dtype), vc)

    n_sel = S // SEL
    js = np.arange(n_sel)[None, :] * SEL
    cs = cmp_start[:, None]
    overlap = np.clip(np.minimum(cs + L, js + SEL) - np.maximum(cs, js), 0, None) / L
    M = jnp.asarray(overlap, dtype=jnp.float32)
    imp = jnp.einsum('bghsc,cj->bgsj', p_c, M)
    cur = (t_idx // SEL)[:, None]
    jb = jnp.arange(n_sel)[None, :]
    forced = (jb == 0) | (jb == cur) | (jb == cur - 1)
    imp = jnp.where(forced, jnp.inf, jnp.where(jb > cur, -jnp.inf, imp))
    _, sel_idx = lax.top_k(imp, min(NSA_TOP_N, n_sel))

    ks_b = ks.reshape(B, n_sel, SEL, G, dh).transpose(0, 3, 1, 2, 4)
    vs_b = vs.reshape(B, n_sel, SEL, G, dh).transpose(0, 3, 1, 2, 4)
    gather_blocks = jax.vmap(jax.vmap(lambda blocks, ix: blocks[ix]))

    QS = NSA_SEL_Q_BLOCK

    def sel_block(qb):
        q0 = qb * QS
        qblk = lax.dynamic_slice_in_dim(q, q0, QS, axis=1)
        ix = lax.dynamic_slice_in_dim(sel_idx, q0, QS, axis=2)
        t = q0 + jnp.arange(QS)
        k_sel = gather_blocks(ks_b, ix)
        v_sel = gather_blocks(vs_b, ix)
        s = jnp.einsum('btghd,bgtnkd->bghtnk', qblk, k_sel).astype(jnp.float32) * scale
        kpos = ix[..., None] * SEL + jnp.arange(SEL)
        mask = (kpos <= t[None, None, :, None, None])[:, :, None]
        s = jnp.where(mask, s, neg)
        sh = s.shape
        pr = jax.nn.softmax(s.reshape(sh[:4] + (-1,)), axis=-1).reshape(sh)
        return jnp.einsum('bghtnk,bgtnkd->btghd', pr.astype(v_sel.dtype), v_sel)

    o_s = lax.map(sel_block, jnp.arange(S // QS))
    o_s = o_s.transpose(1, 0, 2, 3, 4, 5).reshape(B, S, H, dh)

    QW = NSA_WIN_Q_BLOCK
    kw_p = jnp.pad(kw, ((0, 0), (WIN, 0), (0, 0), (0, 0)))
    vw_p = jnp.pad(vw, ((0, 0), (WIN, 0), (0, 0), (0, 0)))

    def win_block(qb):
        q0 = qb * QW
        qblk = lax.dynamic_slice_in_dim(q, q0, QW, axis=1)
        kwin = lax.dynamic_slice_in_dim(kw_p, q0, QW + WIN, axis=1)
        vwin = lax.dynamic_slice_in_dim(vw_p, q0, QW + WIN, axis=1)
        t = q0 + jnp.arange(QW)
        kpos = q0 - WIN + jnp.arange(QW + WIN)
        dist = t[:, None] - kpos[None, :]
        mask = (dist >= 0) & (dist < WIN) & (kpos >= 0)[None, :]
        s = jnp.einsum('btghd,bkgd->bghtk', qblk, kwin).astype(jnp.float32) * scale
        pr = jax.nn.softmax(jnp.where(mask, s, neg), axis=-1)
        return jnp.einsum('bghtk,bkgd->btghd', pr.astype(vwin.dtype), vwin)

    o_w = lax.map(win_block, jnp.arange(S // QW))
    o_w = o_w.transpose(1, 0, 2, 3, 4, 5).reshape(B, S, H, dh)

    gts = jax.nn.sigmoid(gate.reshape(B, S, H, 3))
    o = (gts[..., 0:1] * o_c.reshape(B, S, H, dh) + gts[..., 1:2] * o_s + gts[..., 2:3] * o_w)
    return o.reshape(B, S, H * dh) @ w_out


def s5_mixer(xn, w_in, a_re, a_im, b_re, b_im, c_re, c_im, d_skip, log_dt, w_glu):
    B, S, D = xn.shape
    G, P, Cg = S5_GROUPS, S5_STATE, S5_GROUP
    u = (xn @ w_in).astype(jnp.float32)
    ug = u.reshape(B, S, G, Cg)
    dt = jnp.exp(log_dt.astype(jnp.float32))[:, None]
    ar, ai = a_re.astype(jnp.float32), a_im.astype(jnp.float32)
    mag = jnp.exp(dt * ar)
    abar_re, abar_im = mag * jnp.cos(dt * ai), mag * jnp.sin(dt * ai)
    den = ar * ar + ai * ai
    nr, ni = abar_re - 1.0, abar_im
    f_re = (nr * ar + ni * ai) / den
    f_im = (ni * ar - nr * ai) / den
    br, bi = b_re.astype(jnp.float32), b_im.astype(jnp.float32)
    bbar_re = f_re[..., None] * br - f_im[..., None] * bi
    bbar_im = f_re[..., None] * bi + f_im[..., None] * br
    bu_re = jnp.einsum('bsgc,gpc->sbgp', ug, bbar_re)
    bu_im = jnp.einsum('bsgc,gpc->sbgp', ug, bbar_im)
    la_re = jnp.broadcast_to(abar_re[None, None], (S, 1, G, P))
    la_im = jnp.broadcast_to(abar_im[None, None], (S, 1, G, P))

    def combine(e1, e2):
        a1r, a1i, b1r, b1i = e1
        a2r, a2i, b2r, b2i = e2
        return (a2r * a1r - a2i * a1i, a2r * a1i + a2i * a1r,
                a2r * b1r - a2i * b1i + b2r, a2r * b1i + a2i * b1r + b2i)

    _, _, xr, xi = lax.associative_scan(combine, (la_re, la_im, bu_re, bu_im), axis=0)
    y = (jnp.einsum('sbgp,gcp->bsgc', xr, c_re.astype(jnp.float32))
         - jnp.einsum('sbgp,gcp->bsgc', xi, c_im.astype(jnp.float32)))
    y = y.reshape(B, S, D) + d_skip.astype(jnp.float32) * u
    y = jax.nn.gelu(y).astype(xn.dtype)
    a, b = jnp.split(y @ w_glu, 2, axis=-1)
    return a * jax.nn.sigmoid(b)


def moe_ffn(hn, router, w_gate_up, w_down):
    logits = (hn @ router).astype(jnp.float32)
    top_v, top_i = lax.top_k(logits, TOP_K)
    w = jax.nn.softmax(top_v, axis=-1)
    gates = jnp.sum(jax.nn.one_hot(top_i, N_EXPERTS, dtype=jnp.float32) * w[..., None], axis=-2)
    gates = gates.astype(hn.dtype)
    out = jnp.zeros_like(hn)
    for e in range(N_EXPERTS):
        out = out + gates[..., e:e + 1] * swiglu(hn, w_gate_up[e], w_down[e])
    return out


def setup_inputs(seed: int = 0) -> dict:
    key = jax.random.key(seed)
    keys = iter(jax.random.split(key, 64))
    f32 = jnp.float32
    D = D_MODEL

    def nrm(shape, scale):
        return jax.random.normal(next(keys), shape, f32) * scale

    def gain(shape):
        return 1.0 + 0.05 * jax.random.normal(next(keys), shape, f32)

    n_ret = len(range(0, DEPTH, N_MIXERS))
    n_nsa = len(range(1, DEPTH, N_MIXERS))
    n_s5 = len(range(2, DEPTH, N_MIXERS))
    n_dense = len(range(0, DEPTH, 2))
    n_moe = len(range(1, DEPTH, 2))
    ret_in = 2 * RET_HEADS * RET_DK + 2 * RET_HEADS * RET_DV
    nsa_in = NSA_HEADS * NSA_DH + 6 * NSA_GROUPS * NSA_DH + 3 * NSA_HEADS

    x = nrm((BATCH, SEQ, D), 1.0)
    p = nrm((DEPTH, BATCH, SEQ, PLE_DIM), 1.0)
    positions = (jax.random.randint(next(keys), (BATCH, 1), 0, POS_OFFSET_MAX, jnp.int32)
                 + jnp.arange(SEQ, dtype=jnp.int32)[None, :])
    a_re = -0.5 + 0.01 * jax.random.normal(next(keys), (n_s5, S5_GROUPS, S5_STATE), f32)
    a_im = (jnp.pi * jnp.arange(S5_STATE, dtype=f32)[None, None, :]
            + 0.01 * jax.random.normal(next(keys), (n_s5, S5_GROUPS, S5_STATE), f32))
    return {
        "x": x, "p": p, "positions": positions,
        "norm_mix": gain((DEPTH, D)), "norm_ffn": gain((DEPTH, D)), "norm_ple": gain((DEPTH, D)),
        "ret_w_in": nrm((n_ret, D, ret_in), D ** -0.5),
        "ret_gn": gain((n_ret, RET_HEADS * RET_DV)),
        "ret_w_out": nrm((n_ret, RET_HEADS * RET_DV, D), (RET_HEADS * RET_DV) ** -0.5),
        "nsa_w_in": nrm((n_nsa, D, nsa_in), D ** -0.5),
        "nsa_q_norm": gain((n_nsa, NSA_DH)),
        "nsa_k_norm": gain((n_nsa, 3, NSA_DH)),
        "nsa_cmp_pos": nrm((n_nsa, 2, NSA_CMP_LEN, NSA_DH), 0.1),
        "nsa_cmp_w1": nrm((n_nsa, 2, NSA_CMP_LEN * NSA_DH, NSA_CMP_HID), (NSA_CMP_LEN * NSA_DH) ** -0.5),
        "nsa_cmp_w2": nrm((n_nsa, 2, NSA_CMP_HID, NSA_DH), NSA_CMP_HID ** -0.5),
        "nsa_w_out": nrm((n_nsa, NSA_HEADS * NSA_DH, D), (NSA_HEADS * NSA_DH) ** -0.5),
        "s5_w_in": nrm((n_s5, D, D), D ** -0.5),
        "s5_a_re": a_re, "s5_a_im": a_im,
        "s5_b_re": nrm((n_s5, S5_GROUPS, S5_STATE, S5_GROUP), (2 * S5_GROUP) ** -0.5),
        "s5_b_im": nrm((n_s5, S5_GROUPS, S5_STATE, S5_GROUP), (2 * S5_GROUP) ** -0.5),
        "s5_c_re": nrm((n_s5, S5_GROUPS, S5_GROUP, S5_STATE), (2 * S5_STATE) ** -0.5),
        "s5_c_im": nrm((n_s5, S5_GROUPS, S5_GROUP, S5_STATE), (2 * S5_STATE) ** -0.5),
        "s5_d": nrm((n_s5, D), 0.5),
        "s5_log_dt": jax.random.uniform(next(keys), (n_s5, S5_GROUPS), f32, math.log(1e-3), math.log(1e-1)),
        "s5_w_glu": nrm((n_s5, D, 2 * D), D ** -0.5),
        "ffn_w_gate_up": nrm((n_dense, D, 2 * D_FF), D ** -0.5),
        "ffn_w_down": nrm((n_dense, D_FF, D), D_FF ** -0.5),
        "moe_router": nrm((n_moe, D, N_EXPERTS), D ** -0.5),
        "moe_w_gate_up": nrm((n_moe, N_EXPERTS, D, 2 * D_FF_EXPERT), D ** -0.5),
        "moe_w_down": nrm((n_moe, N_EXPERTS, D_FF_EXPERT, D), D_FF_EXPERT ** -0.5),
        "ple_w_proj": nrm((DEPTH, PLE_DIM, D), PLE_DIM ** -0.5),
        "ple_w_gate": nrm((DEPTH, D, D), D ** -0.5),
    }


def reference(x, p, positions, norm_mix, norm_ffn, norm_ple,
              ret_w_in, ret_gn, ret_w_out,
              nsa_w_in, nsa_q_norm, nsa_k_norm, nsa_cmp_pos, nsa_cmp_w1, nsa_cmp_w2, nsa_w_out,
              s5_w_in, s5_a_re, s5_a_im, s5_b_re, s5_b_im, s5_c_re, s5_c_im, s5_d, s5_log_dt, s5_w_glu,
              ffn_w_gate_up, ffn_w_down,
              moe_router, moe_w_gate_up, moe_w_down,
              ple_w_proj, ple_w_gate):
    h = x
    for i in range(DEPTH):
        m, j = i % N_MIXERS, i // N_MIXERS
        hn = rms_norm(h, norm_mix[i])
        if m == 0:
            y = retention_mixer(hn, positions, ret_w_in[j], ret_gn[j], ret_w_out[j])
        elif m == 1:
            y = nsa_mixer(hn, positions, nsa_w_in[j], nsa_q_norm[j], nsa_k_norm[j], nsa_cmp_pos[j],
                          nsa_cmp_w1[j], nsa_cmp_w2[j], nsa_w_out[j])
        else:
            y = s5_mixer(hn, s5_w_in[j], s5_a_re[j], s5_a_im[j], s5_b_re[j], s5_b_im[j],
                         s5_c_re[j], s5_c_im[j], s5_d[j], s5_log_dt[j], s5_w_glu[j])
        h = h + y.astype(h.dtype)
        hn = rms_norm(h, norm_ffn[i])
        if i % 2 == 0:
            f = swiglu(hn, ffn_w_gate_up[i // 2], ffn_w_down[i // 2])
        else:
            f = moe_ffn(hn, moe_router[i // 2], moe_w_gate_up[i // 2], moe_w_down[i // 2])
        h = h + f.astype(h.dtype)
        gate = jax.nn.sigmoid(rms_norm(h, norm_ple[i]) @ ple_w_gate[i])
        h = h + (gate * (p[i] @ ple_w_proj[i])).astype(h.dtype)
    return h
```

```cpp
#ifndef HOST_SIM
#include <hip/hip_runtime.h>
#endif
#include <cstdio>
#include <cstdint>
#include <cmath>
#include <cstring>

#ifdef SMALL
constexpr int D = 128, NB = 2, S = 2048, PLE = 32, RH = 2, RC = 64, NH = 8, NG = 2, CL = 32, CSTR = 16, SELB = 64, TOPN = 16, WIN = 512,
              CHID = 64, SGC = 16, SP = 64, DFF = 352, NE = 8, DFE = 448, IB = 32, BN = 64, PT_K = 32;
#else
constexpr int D = 1024, NB = 16, S = 2048, PLE = 256, RH = 4, RC = 64, NH = 8, NG = 2, CL = 32, CSTR = 16, SELB = 64, TOPN = 16, WIN = 512,
              CHID = 256, SGC = 16, SP = 64, DFF = 2816, NE = 8, DFE = 3584, IB = 128, BN = 256, PT_K = 64;
#endif
constexpr int T = NB * S, DEPTH = 4, BMR = 256;
constexpr float NORM_EPS = 1e-6f, ROPE_LN_THETA = 9.210340371976184f;
constexpr int RDK = D / RH, RDV = 2 * RDK, RIN = 2 * RH * RDK + 2 * RH * RDV, RVW = RH * RDV;
constexpr int NDH = D / NH, HG = NH / NG, KVW = NG * NDH, NSA_IN = NH * NDH + 6 * KVW + 3 * NH, NSA_INP = ((NSA_IN + BN - 1) / BN) * BN;
constexpr int NCB = S / CSTR, NCV = (S - CL) / CSTR + 1, NSEL = S / SELB, CK = CL * NDH, CLDA = CSTR * NDH, CMP_M = NB * NG * NCB;
constexpr int SG = D / SGC;
constexpr int MOE_ROWS = 2 * T + NE * BMR;
constexpr int NT = 512, NWV = 8;
static_assert(BN == 2 * IB && DFF % IB == 0 && DFE % IB == 0 && D % IB == 0 && RDK == BN, "gated interleave / one retention head per column tile");
static_assert(NSEL <= 32 && NCV <= 128 && CHID == BN && T % BMR == 0 && CMP_M % BMR == 0, "shape assumptions");

typedef unsigned short bf16;
#ifdef HOST_SIM
#define HD inline
#define DEV inline
#else
#define HD __host__ __device__ __forceinline__
#define DEV __device__ __forceinline__
#endif
struct alignas(16) F4 { float x, y, z, w; };
struct alignas(16) U4 { unsigned x, y, z, w; };
struct alignas(8) U2 { unsigned x, y; };
HD float bf2f(bf16 b) { unsigned u = (unsigned)b << 16; return __builtin_bit_cast(float, u); }
#ifdef HOST_SIM
HD bf16 f2bf(float f) { unsigned u = __builtin_bit_cast(unsigned, f); u += 0x7fffu + ((u >> 16) & 1u); return (bf16)(u >> 16); }
HD unsigned pk2(float lo, float hi) { return (unsigned)f2bf(lo) | ((unsigned)f2bf(hi) << 16); }
#else
__device__ __forceinline__ unsigned pk2(float lo, float hi) { unsigned r; asm("v_cvt_pk_bf16_f32 %0, %1, %2" : "=v"(r) : "v"(lo), "v"(hi)); return r; }
__device__ __forceinline__ bf16 f2bf(float f) { return (bf16)(pk2(f, f) & 0xffffu); }
#endif
#ifdef HOST_SIM
HD float fexp2_(float x) { return exp2f(x); }
HD float flog2_(float x) { return log2f(x); }
#else
HD float fexp2_(float x) { return __builtin_amdgcn_exp2f(x); }
HD float flog2_(float x) { return __builtin_amdgcn_logf(x); }
#endif
HD void rope_cs_(float pos, int i2, int d, float& cs, float& sn) {
#ifdef HOST_SIM
    const float inv = expf(-(float)i2 / (float)d * ROPE_LN_THETA), ang = pos * inv; cs = cosf(ang); sn = sinf(ang);
#else
    const float inv = __builtin_amdgcn_exp2f(-(float)i2 / (float)d * 13.287712379549449f);
    const float rev = __builtin_amdgcn_fractf(pos * inv * 0.15915494309189535f); cs = __builtin_amdgcn_cosf(rev); sn = __builtin_amdgcn_sinf(rev);
#endif
}
HD float log2_gamma_(int h) { return flog2_(1.0f - fexp2_(-5.0f - (float)h)); }
typedef unsigned char fp8;
#ifndef GU8_MASK
#define GU8_MASK 0x4u
#endif
#ifndef DN8_MASK
#define DN8_MASK 0x4u
#endif
static_assert((GU8_MASK & ~DN8_MASK) == 0, "fp8 gate-up needs the fp8 down-projection");
constexpr float F8S_X = 8.0f, F8S_WGU = 128.0f, F8S_ACT = 8.0f, F8S_WDN = 256.0f;
HD float f82f(fp8 v) { const int e = (v >> 3) & 15, m = v & 7; const float r = e ? ldexpf(1.0f + (float)m * 0.125f, e - 7) : ldexpf((float)m * 0.125f, -6); return (v & 0x80) ? -r : r; }
HD fp8 f2f8_sw(float x) {
    const unsigned sgn = x < 0.f ? 0x80u : 0u; float a = fabsf(x); if (!(a < 448.0f)) return (fp8)(sgn | 0x7Eu);
    if (a < 0.015625f) return (fp8)(sgn | (unsigned)rintf(a * 512.0f));
    int ex; (void)frexpf(a, &ex); int eu = ex - 1; int m = (int)rintf((ldexpf(a, -eu) - 1.0f) * 8.0f); if (m == 8) { m = 0; ++eu; }
    unsigned code = ((unsigned)(eu + 7) << 3) | (unsigned)m; if (code > 0x7Eu) code = 0x7Eu; return (fp8)(sgn | code); }
#ifdef HOST_SIM
HD unsigned pk4_f8(float a, float b, float c, float d) { return (unsigned)f2f8_sw(a) | ((unsigned)f2f8_sw(b) << 8) | ((unsigned)f2f8_sw(c) << 16) | ((unsigned)f2f8_sw(d) << 24); }
#else
__device__ __forceinline__ float clamp448_(float x) { return __builtin_amdgcn_fmed3f(x, -448.0f, 448.0f); }
__device__ __forceinline__ unsigned pk4_f8(float a, float b, float c, float d) { int w = __builtin_amdgcn_cvt_pk_fp8_f32(clamp448_(a), clamp448_(b), 0, false); w = __builtin_amdgcn_cvt_pk_fp8_f32(clamp448_(c), clamp448_(d), w, true); return (unsigned)w; }
#endif
#ifdef HOST_SIM
HD float sigmoidf_(float x) { return 1.0f / (1.0f + expf(-x)); }
HD float geluf_(float x) { return 0.5f * x * (1.0f + tanhf(0.7978845608028654f * (x + 0.044715f * x * x * x))); }
#else
HD float sigmoidf_(float x) { return __builtin_amdgcn_rcpf(1.0f + __builtin_amdgcn_exp2f(-1.4426950408889634f * x)); }
HD float geluf_(float x) { const float u2 = 1.5957691216057308f * (x + 0.044715f * x * x * x); return x * sigmoidf_(u2); }
#endif
HD float siluf_(float x) { return x * sigmoidf_(x); }

constexpr size_t al256(size_t x) { return (x + 255) & ~(size_t)255; }
constexpr size_t OFF_CTL = 0, CTL_BYTES = 1u << 20;
constexpr size_t OFF_H = CTL_BYTES;
constexpr size_t OFF_XN = OFF_H + al256((size_t)T * D * 4);
constexpr size_t OFF_PB = OFF_XN + al256((size_t)T * D * 2);
constexpr size_t OFF_PROJ = OFF_PB + al256((size_t)T * PLE * 2);
constexpr size_t OFF_TOPI = OFF_PROJ + al256((size_t)T * D * 2);
constexpr size_t OFF_TOPW = OFF_TOPI + al256((size_t)T * 2 * 4);
constexpr size_t OFF_SLOT = OFF_TOPW + al256((size_t)T * 2 * 4);
constexpr size_t OFF_ROWS = OFF_SLOT + al256((size_t)T * 2 * 4);
constexpr size_t OFF_CMPB = OFF_ROWS + al256((size_t)MOE_ROWS * 4);
constexpr size_t OFF_S5AB = OFF_CMPB + al256((size_t)2 * CHID * 4);
constexpr size_t OFF_S5BB = OFF_S5AB + al256((size_t)SG * SP * 4 * 4);
constexpr size_t OFF_SELM = OFF_S5BB + al256((size_t)SG * SP * SGC * 2 * 4);
constexpr size_t OFF_GT = OFF_SELM + al256((size_t)T * NG * 4);
constexpr size_t OFF_RINV = OFF_GT + al256((size_t)T * NH * 3 * 4);
constexpr int NPS = 32;
constexpr size_t OFF_SSQ = OFF_RINV + al256((size_t)T * 4);
constexpr size_t OFF_W_RIN = OFF_SSQ + al256((size_t)T * NPS * 4);
constexpr size_t OFF_W_ROUT = OFF_W_RIN + al256((size_t)RIN * D * 2);
constexpr size_t OFF_W_NIN = OFF_W_ROUT + al256((size_t)D * RVW * 2);
constexpr size_t OFF_W_CMP = OFF_W_NIN + al256((size_t)NSA_INP * D * 2);
constexpr size_t OFF_W_CMP2 = OFF_W_CMP + al256((size_t)2 * CHID * CK * 2);
constexpr size_t OFF_W_NOUT = OFF_W_CMP2 + al256((size_t)2 * NDH * CHID * 2);
constexpr size_t OFF_W_SIN = OFF_W_NOUT + al256((size_t)D * D * 2);
constexpr size_t OFF_W_SGLU = OFF_W_SIN + al256((size_t)D * D * 2);
constexpr size_t OFF_W_FGU = OFF_W_SGLU + al256((size_t)2 * D * D * 2);
constexpr size_t OFF_W_FDN = OFF_W_FGU + al256((size_t)2 * DFF * D * 2);
constexpr size_t OFF_W_MGU = OFF_W_FDN + al256((size_t)D * DFF * 2);
constexpr size_t OFF_W_MDN = OFF_W_MGU + al256((size_t)NE * 2 * DFE * D * 2);
constexpr size_t OFF_W_PPROJ = OFF_W_MDN + al256((size_t)NE * D * DFE * 2);
constexpr size_t OFF_W_PGATE = OFF_W_PPROJ + al256((size_t)D * PLE * 2);
constexpr size_t OFF_SCR = OFF_W_PGATE + al256((size_t)D * D * 2);
constexpr size_t SC_RET_RAW = 0, SC_RET_KT = al256((size_t)T * RIN * 2), SC_RET_VT = SC_RET_KT + al256((size_t)T * RH * RDK * 2), SC_RET_END = SC_RET_VT + al256((size_t)T * RVW * 2);
constexpr size_t SC_FFN_ACT = 0, SC_FFN_END = al256((size_t)T * DFF * 2);
constexpr size_t SC_MOE_ACT = 0, SC_MOE_Y = al256((size_t)MOE_ROWS * DFE * 2), SC_MOE_END = SC_MOE_Y + al256((size_t)MOE_ROWS * D * 2);
constexpr size_t SC_S5_U = 0, SC_S5_Y = al256((size_t)T * D * 2), SC_S5_END = 2 * al256((size_t)T * D * 2);
constexpr size_t KVB = al256((size_t)(NB * NG * S * NDH + CK) * 2);
constexpr size_t SC_N_RAW = 0, SC_N_QN = al256((size_t)T * NSA_INP * 2), SC_N_KS = SC_N_QN + al256((size_t)T * D * 2), SC_N_VS = SC_N_KS + KVB, SC_N_KW = SC_N_VS + KVB,
                 SC_N_VW = SC_N_KW + KVB, SC_N_KCR = SC_N_VW + KVB, SC_N_VCR = SC_N_KCR + KVB, SC_N_HID = SC_N_VCR + KVB, SC_N_KC = SC_N_HID + al256((size_t)2 * CMP_M * CHID * 2),
                 SC_N_VC = SC_N_KC + al256((size_t)CMP_M * NDH * 2), SC_N_OC = SC_N_VC + al256((size_t)CMP_M * NDH * 2), SC_N_OS = SC_N_OC + al256((size_t)T * D * 2),
                 SC_N_OW = SC_N_OS + al256((size_t)T * D * 2), SC_N_END = SC_N_OW + al256((size_t)T * D * 2);
constexpr size_t cmax(size_t a, size_t b) { return a > b ? a : b; }
constexpr size_t SCR_BYTES = cmax(cmax(SC_RET_END, SC_FFN_END), cmax(cmax(SC_MOE_END, SC_S5_END), SC_N_END));
constexpr size_t WS_NEED = OFF_SCR + SCR_BYTES;
constexpr int CW_BAR = 4096;
constexpr int CW_MOE = 8192;

enum { I_X = 0, I_P, I_POS, I_NMIX, I_NFFN, I_NPLE, I_RWIN, I_RGN, I_RWOUT, I_NWIN, I_NQN, I_NKN, I_NCPOS, I_NCW1, I_NCW2, I_NWOUT, I_SWIN, I_SARE, I_SAIM, I_SBRE, I_SBIM,
       I_SCRE, I_SCIM, I_SD, I_SLDT, I_SWGLU, I_FWGU, I_FWDN, I_MROUTER, I_MWGU, I_MWDN, I_PWPROJ, I_PWGATE, N_INPUTS };

struct Args { const float* in[N_INPUTS]; float* out; unsigned char* ws; int ph_lo, ph_hi; };

#ifdef HOST_SIM
struct Ctx { int bid, nblk; unsigned char* lds; int tid, lane, wave; unsigned char* ws; const Args* args; };
#define IN(i) (cx.args->in[i])
#define OUTP (cx.args->out)
#define FOR_THREADS(t) for (int t = 0; t < NT; ++t)
#define BLOCK_SYNC() ((void)0)
#define GRID_FOR(i, n) for (long i = cx.bid; i < (long)(n); i += cx.nblk)
#define ROW_FOR(r, n) for (long r = cx.bid; r < (long)(n); r += cx.nblk)
#define LANE_FOR(c, n) for (int c = 0; c < (n); ++c)
#define LANE_SLOTS(n) (n)
#define LANE_FOR_S(slot, c, n) for (int slot = 0, c = 0; c < (n); ++c, ++slot)
#define WAVE_SUM(x) (x)
#define WAVE_BCAST0(x) (x)
#define LANE0 true
#define ATOMIC_ADD(p, v) __atomic_fetch_add((p), (v), __ATOMIC_RELAXED)
#define LDS_ATOMIC_ADD(p, v) __atomic_fetch_add((p), (v), __ATOMIC_RELAXED)
#define LDSP(type, off) ((type*)(cx.lds + (off)))
#else
#define LAS __attribute__((address_space(3)))
struct Ctx { int bid, nblk; LAS unsigned char* lds; int tid, lane, wave; unsigned char* ws; };
constexpr int LDS_BYTES = 163840, LDS_MISC = 155648 + 320, LDS_TAB = 155648 + 1024;
__device__ __forceinline__ const float* in_ptr_(const Ctx& cx, int i) {
    const LAS unsigned* p = (const LAS unsigned*)(cx.lds + LDS_TAB) + 2 * i; const unsigned lo = __builtin_amdgcn_readfirstlane(p[0]), hi = __builtin_amdgcn_readfirstlane(p[1]);
    return (const float*)(__attribute__((address_space(1))) const float*)(((unsigned long long)hi << 32) | lo); }
#define IN(i) in_ptr_(cx, (i))
#define OUTP ((float*)in_ptr_(cx, N_INPUTS))
#define FOR_THREADS(t) for (int t = cx.tid, _once = 1; _once; _once = 0)
#define BLOCK_SYNC() __syncthreads()
#define GRID_FOR(i, n) for (long i = (long)cx.bid * NT + cx.tid; i < (long)(n); i += (long)cx.nblk * NT)
#define ROW_FOR(r, n) for (long r = (long)cx.bid * NWV + cx.wave; r < (long)(n); r += (long)cx.nblk * NWV)
#define LANE_FOR(c, n) for (int c = cx.lane; c < (n); c += 64)
#define LANE_SLOTS(n) ((n) / 64)
#define LANE_FOR_S(slot, c, n) _Pragma("unroll") for (int slot = 0, c = cx.lane; slot < LANE_SLOTS(n); ++slot, c += 64)
__device__ __forceinline__ float wave_sum_(float v) {
#pragma unroll
    for (int o = 1; o < 64; o <<= 1) v += __shfl_xor(v, o);
    return v;
}
#define WAVE_SUM(x) wave_sum_(x)
#define WAVE_BCAST0(x) __builtin_amdgcn_readfirstlane(x)
#define LANE0 (cx.lane == 0)
#define ATOMIC_ADD(p, v) atomicAdd((p), (v))
#define LDS_ATOMIC_ADD(p, v) __hip_atomic_fetch_add((p), (v), __ATOMIC_RELAXED, __HIP_MEMORY_SCOPE_WORKGROUP)
#define LDSP(type, off) ((LAS type*)(cx.lds + (off)))
#endif

#ifdef HOST_SIM
#define UNI_I(x) (x)
template <class P> inline P* uni_ptr(P* p) { return p; }
#else
#define UNI_I(x) __builtin_amdgcn_readfirstlane(x)
template <class P> __device__ __forceinline__ P* uni_ptr(P* p) { const unsigned long long v = (unsigned long long)p; const unsigned lo = __builtin_amdgcn_readfirstlane((unsigned)v), hi = __builtin_amdgcn_readfirstlane((unsigned)(v >> 32));
    return (P*)(__attribute__((address_space(1))) P*)(((unsigned long long)hi << 32) | lo); }
#endif
struct GUnit { const bf16* A; const bf16* B; const int* rows; int pm, pn, aux; };
constexpr int NXCD = 8, WGM = 8;
struct SchedDense {
    static constexpr bool GATHER = false;
    const bf16* A; const bf16* B; int lda, ldb, nM, nN, G, c;
    HD bool next(int i, GUnit& u) const {
        const long L = (long)i * G + c; const int nwg = nM * nN; if (c < 0 || L >= nwg) return false;
        int wgid = (int)L; { const int q = nwg / NXCD, r = nwg % NXCD, xcd = wgid % NXCD, off = wgid / NXCD; wgid = (xcd < r ? xcd * (q + 1) : r * (q + 1) + (xcd - r) * q) + off; }
        const int nig = WGM * nN, gid = wgid / nig, fm = gid * WGM, gsz = (nM - fm) < WGM ? (nM - fm) : WGM;
        u.pm = fm + ((wgid % nig) % gsz); u.pn = (wgid % nig) / gsz; u.aux = 0; u.rows = nullptr;
        u.A = uni_ptr(A + (size_t)u.pm * BMR * lda); u.B = uni_ptr(B + (size_t)u.pn * BN * ldb); return true;
    }
};
struct SchedCmp {
    static constexpr bool GATHER = false;
    const bf16* A0; const bf16* A1; const bf16* W; int G, c;
    HD bool next(int i, GUnit& u) const {
        const int L = i * G + c, nm = CMP_M / BMR; if (L >= 2 * nm) return false;
        const int kv = L / nm, pm = L % nm; u.pm = pm; u.pn = 0; u.aux = kv; u.rows = nullptr;
        u.A = uni_ptr((kv ? A1 : A0) + (size_t)pm * BMR * CLDA); u.B = uni_ptr(W + (size_t)kv * CHID * CK); return true;
    }
};
template <bool GATH> struct SchedMoE {
    static constexpr bool GATHER = GATH;
    const bf16* A; const bf16* W; const int* rows; int lda, wstride  , ldb, nN, G, c; int tl[NE + 1];
    HD void init(const int* cnt) { tl[0] = 0;
#pragma unroll
        for (int e = 0; e < NE; ++e) tl[e + 1] = tl[e] + (UNI_I(cnt[e]) + BMR - 1) / BMR; }
    HD bool next(int i, GUnit& u) const {
        const long L = (long)i * G + c; const int nM = tl[NE], nwg = nM * nN; if (L >= nwg) return false;
        int wgid = (int)L; { const int q = nwg / NXCD, r = nwg % NXCD, xcd = wgid % NXCD, off = wgid / NXCD; wgid = (xcd < r ? xcd * (q + 1) : r * (q + 1) + (xcd - r) * q) + off; }
        const int nig = WGM * nN, gid = wgid / nig, fm = gid * WGM, gsz = (nM - fm) < WGM ? (nM - fm) : WGM;
        const int rt = fm + ((wgid % nig) % gsz), pn = (wgid % nig) / gsz; int e = 0;
#pragma unroll
        for (int k = 1; k < NE; ++k) if (rt >= tl[k]) e = k;
        u.pm = rt; u.pn = pn; u.aux = e; u.B = uni_ptr(W + (size_t)e * wstride + (size_t)pn * BN * ldb);
        if (GATH) { u.rows = uni_ptr(rows + (size_t)rt * BMR); u.A = uni_ptr(A); } else { u.rows = nullptr; u.A = uni_ptr(A + (size_t)rt * BMR * lda); }
        return true;
    }
};
template <class E, class = void> struct has_rsc { static constexpr bool v = false; };
template <class E> struct has_rsc<E, decltype((void)E::RSC)> { static constexpr bool v = true; };
template <class E, class = void> struct has_hpre { static constexpr bool v = false; };
template <class E> struct has_hpre<E, decltype((void)E::HB)> { static constexpr bool v = true; };
template <class E, class = void> struct has_ssq { static constexpr bool v = false; };
template <class E> struct has_ssq<E, decltype((void)E::SSQ)> { static constexpr bool v = true; };
struct EStoreBf16 { static constexpr bool GATED = false, PERM = true; bf16* O; int ldo;
    HD void vec8(const GUnit& u, int r, int c0, const float* v) const { U4 w; w.x = pk2(v[0], v[1]); w.y = pk2(v[2], v[3]); w.z = pk2(v[4], v[5]); w.w = pk2(v[6], v[7]);
        *(U4*)(O + (size_t)(u.pm * BMR + r) * ldo + u.pn * BN + c0) = w; } };
struct EStoreBf16R { static constexpr bool GATED = false, PERM = true, RSC = true; bf16* O; int ldo; const float* rs;
    HD void vec8(const GUnit& u, int r, int c0, const float* v) const { EStoreBf16{O, ldo}.vec8(u, r, c0, v); } };
struct ERetIn { static constexpr bool GATED = true, PERM = true, RSC = true; bf16* RAW; bf16* KT; bf16* VT; const int* pos; const float* rs;
    static constexpr bool ROWPRE = true;
    HD float rowpre(const GUnit& u, int r) const { return u.pn < 2 * RH ? (float)pos[(size_t)u.pm * BMR + r] : 0.f; }
    HD void vec8g(const GUnit& u, int r, int j0, const float* a, const float* b2) const { vec8gp(u, r, j0, a, b2, rowpre(u, r)); }
    HD void vec8gp(const GUnit& u, int r, int j0, const float* a, const float* b2, float pp) const {
        const size_t row = (size_t)u.pm * BMR + r; const int pn = u.pn; bf16* rp = RAW + row * RIN + pn * BN + j0; const size_t bb = row / S, sx = row % S;
        if (pn < 2 * RH) { const int which = pn / RH, h = pn % RH;
            const float sc = which ? fexp2_((float)(RC - 1 - (int)(row % RC)) * log2_gamma_(h)) * (1.0f / sqrtf((float)RDK)) : 1.0f;
            float o1[8], o2[8];
#pragma unroll
            for (int e = 0; e < 8; ++e) { float cs, sn; rope_cs_(pp, 2 * (j0 + e), RDK, cs, sn); o1[e] = (a[e] * cs - b2[e] * sn) * sc; o2[e] = (b2[e] * cs + a[e] * sn) * sc; }
            U4 w1, w2; w1.x = pk2(o1[0], o1[1]); w1.y = pk2(o1[2], o1[3]); w1.z = pk2(o1[4], o1[5]); w1.w = pk2(o1[6], o1[7]); w2.x = pk2(o2[0], o2[1]); w2.y = pk2(o2[2], o2[3]); w2.z = pk2(o2[4], o2[5]); w2.w = pk2(o2[6], o2[7]);
            *(U4*)rp = w1; *(U4*)(rp + IB) = w2;
        } else { U4 w1, w2; w1.x = pk2(a[0], a[1]); w1.y = pk2(a[2], a[3]); w1.z = pk2(a[4], a[5]); w1.w = pk2(a[6], a[7]); w2.x = pk2(b2[0], b2[1]); w2.y = pk2(b2[2], b2[3]); w2.z = pk2(b2[4], b2[5]); w2.w = pk2(b2[6], b2[7]);
            *(U4*)rp = w1; *(U4*)(rp + IB) = w2; }
    } };
HD void ld8h(const bf16* p, float* h) { const U4 w = *(const U4*)p; h[0] = bf2f((bf16)(w.x & 0xffffu)); h[1] = bf2f((bf16)(w.x >> 16)); h[2] = bf2f((bf16)(w.y & 0xffffu)); h[3] = bf2f((bf16)(w.y >> 16));
    h[4] = bf2f((bf16)(w.z & 0xffffu)); h[5] = bf2f((bf16)(w.z >> 16)); h[6] = bf2f((bf16)(w.w & 0xffffu)); h[7] = bf2f((bf16)(w.w >> 16)); }
HD void up8h(const U4& w, float* h) { h[0] = bf2f((bf16)(w.x & 0xffffu)); h[1] = bf2f((bf16)(w.x >> 16)); h[2] = bf2f((bf16)(w.y & 0xffffu)); h[3] = bf2f((bf16)(w.y >> 16));
    h[4] = bf2f((bf16)(w.z & 0xffffu)); h[5] = bf2f((bf16)(w.z >> 16)); h[6] = bf2f((bf16)(w.w & 0xffffu)); h[7] = bf2f((bf16)(w.w >> 16)); }
HD void st8h(bf16* p, const float* h) { U4 w; w.x = pk2(h[0], h[1]); w.y = pk2(h[2], h[3]); w.z = pk2(h[4], h[5]); w.w = pk2(h[6], h[7]); *(U4*)p = w; }
struct EResAdd { static constexpr bool GATED = false, PERM = true, SSQ = true; static constexpr int HB = 4; bf16* Hm; float sg; float* ssq;
    struct Pre { U4 a, b; };
    HD float upd(bf16* p, const U4& raw, const float* v) const { float h[8], q = 0.f; up8h(raw, h);
#pragma unroll
        for (int i = 0; i < 8; ++i) { h[i] += sg * v[i]; q += h[i] * h[i]; }
        st8h(p, h); return q; }
    HD float vec8(const GUnit& u, int r, int c0, const float* v) const { bf16* p = Hm + (size_t)(u.pm * BMR + r) * D + u.pn * BN + c0; return upd(p, *(const U4*)p, v); }
    HD Pre hload(const GUnit& u, int r, int c0) const { const bf16* p = Hm + (size_t)(u.pm * BMR + r) * D + u.pn * BN + c0; Pre x; x.a = *(const U4*)p; x.b = *(const U4*)(p + BN / 2); return x; }
    HD float vec8p(const GUnit& u, int r, int c0, const float* v0, const float* v1, const Pre& x) const { bf16* p = Hm + (size_t)(u.pm * BMR + r) * D + u.pn * BN + c0; return upd(p, x.a, v0) + upd(p + BN / 2, x.b, v1); } };
struct ESwiGLU { static constexpr bool GATED = true, PERM = true, RSC = true; bf16* ACT; int ld; const float* rs;
    HD void vec8g(const GUnit& u, int r, int j0, const float* g, const float* up) const { float o[8];
#pragma unroll
        for (int i = 0; i < 8; ++i) o[i] = siluf_(g[i]) * up[i];
        U4 w; w.x = pk2(o[0], o[1]); w.y = pk2(o[2], o[3]); w.z = pk2(o[4], o[5]); w.w = pk2(o[6], o[7]);
        *(U4*)(ACT + (size_t)(u.pm * BMR + r) * ld + u.pn * IB + j0) = w; } };
struct ESwiGLU8R { static constexpr bool GATED = true, PERM = true, RSC = true; fp8* ACT; int ld; const float* rs;
    HD void vec8g(const GUnit& u, int r, int j0, const float* g, const float* up) const { float o[8];
#pragma unroll
        for (int i = 0; i < 8; ++i) o[i] = siluf_(g[i]) * up[i] * F8S_ACT;
        U2 w; w.x = pk4_f8(o[0], o[1], o[2], o[3]); w.y = pk4_f8(o[4], o[5], o[6], o[7]); *(U2*)(ACT + (size_t)(u.pm * BMR + r) * ld + u.pn * IB + j0) = w; } };
struct ESwiGLU8 { static constexpr bool GATED = true, PERM = true; fp8* ACT; int ld; float inv;
    HD void vec8g(const GUnit& u, int r, int j0, const float* g, const float* up) const { float o[8];
#pragma unroll
        for (int i = 0; i < 8; ++i) o[i] = siluf_(g[i] * inv) * (up[i] * inv) * F8S_ACT;
        U2 w; w.x = pk4_f8(o[0], o[1], o[2], o[3]); w.y = pk4_f8(o[4], o[5], o[6], o[7]); *(U2*)(ACT + (size_t)(u.pm * BMR + r) * ld + u.pn * IB + j0) = w; } };
struct EStoreBf16S { static constexpr bool GATED = false, PERM = true; bf16* O; int ldo; float sc;
    HD void vec8(const GUnit& u, int r, int c0, const float* v) const { U4 w; w.x = pk2(v[0] * sc, v[1] * sc); w.y = pk2(v[2] * sc, v[3] * sc); w.z = pk2(v[4] * sc, v[5] * sc); w.w = pk2(v[6] * sc, v[7] * sc);
        *(U4*)(O + (size_t)(u.pm * BMR + r) * ldo + u.pn * BN + c0) = w; } };
struct EGlu { static constexpr bool GATED = true, PERM = true, SSQ = true; static constexpr int HB = 4; bf16* Hm; float sg; float* ssq;
    struct Pre { U4 a; };
    HD float upd(bf16* p, const U4& raw, const float* a, const float* b) const { float h[8], q = 0.f; up8h(raw, h);
#pragma unroll
        for (int i = 0; i < 8; ++i) { h[i] += sg * a[i] * sigmoidf_(b[i]); q += h[i] * h[i]; }
        st8h(p, h); return q; }
    HD float vec8g(const GUnit& u, int r, int j0, const float* a, const float* b) const { bf16* p = Hm + (size_t)(u.pm * BMR + r) * D + u.pn * IB + j0; return upd(p, *(const U4*)p, a, b); }
    HD Pre hload(const GUnit& u, int r, int j0) const { Pre x; x.a = *(const U4*)(Hm + (size_t)(u.pm * BMR + r) * D + u.pn * IB + j0); return x; }
    HD float vec8p(const GUnit& u, int r, int j0, const float* a, const float* b, const Pre& x) const { return upd(Hm + (size_t)(u.pm * BMR + r) * D + u.pn * IB + j0, x.a, a, b); } };
struct EPle { static constexpr bool GATED = false, PERM = true, RSC = true, SSQ = true; static constexpr int HB = 2; const bf16* Hin; bf16* Hb; float* Hf; const bf16* PROJ; float sg; const float* rs; float* ssq;
    struct Pre { U4 h0, h1, p0, p1; };
    HD float upd(size_t i, const U4& hraw, const U4& praw, const float* v) const { float h[8], pj[8], q = 0.f; up8h(hraw, h); up8h(praw, pj);
#pragma unroll
        for (int e = 0; e < 8; ++e) { h[e] += sg * sigmoidf_(v[e]) * pj[e]; q += h[e] * h[e]; }
        if (Hf) { F4 o0, o1; o0.x = h[0]; o0.y = h[1]; o0.z = h[2]; o0.w = h[3]; o1.x = h[4]; o1.y = h[5]; o1.z = h[6]; o1.w = h[7]; *(F4*)(Hf + i) = o0; *(F4*)(Hf + i + 4) = o1; }
        else st8h(Hb + i, h);
        return q; }
    HD float vec8(const GUnit& u, int r, int c0, const float* v) const { const size_t i = (size_t)(u.pm * BMR + r) * D + u.pn * BN + c0; return upd(i, *(const U4*)(Hin + i), *(const U4*)(PROJ + i), v); }
    HD Pre hload(const GUnit& u, int r, int c0) const { const size_t i = (size_t)(u.pm * BMR + r) * D + u.pn * BN + c0; Pre x; x.h0 = *(const U4*)(Hin + i); x.h1 = *(const U4*)(Hin + i + BN / 2); x.p0 = *(const U4*)(PROJ + i); x.p1 = *(const U4*)(PROJ + i + BN / 2); return x; }
    HD float vec8p(const GUnit& u, int r, int c0, const float* v0, const float* v1, const Pre& x) const { const size_t i = (size_t)(u.pm * BMR + r) * D + u.pn * BN + c0; return upd(i, x.h0, x.p0, v0) + upd(i + BN / 2, x.h1, x.p1, v1); } };
struct ECmp { static constexpr bool GATED = false, PERM = true; bf16* HID; const float* bias;
    HD void vec8(const GUnit& u, int r, int c0, const float* v) const { float o[8];
#pragma unroll
        for (int i = 0; i < 8; ++i) o[i] = geluf_(v[i] + bias[u.aux * CHID + c0 + i]);
        U4 w; w.x = pk2(o[0], o[1]); w.y = pk2(o[2], o[3]); w.z = pk2(o[4], o[5]); w.w = pk2(o[6], o[7]);
        *(U4*)(HID + ((size_t)u.aux * CMP_M + u.pm * BMR + r) * CHID + c0) = w; } };

#ifdef HOST_SIM
template <bool F8 = false, class Epi, class Sched> inline void gemm_run(const Ctx& cx, int lda, int ldb, int K, const Sched& Sc, const Epi& E) {
    GUnit u;
    for (int i = 0; Sc.next(i, u); ++i)
        for (int r = 0; r < BMR; ++r) {
            float accs[BN];
            if constexpr (F8) { const fp8* a = (const fp8*)u.A + (size_t)r * lda;
                for (int c = 0; c < BN; ++c) { const fp8* b = (const fp8*)u.B + (size_t)c * ldb; float s = 0.f; for (int k = 0; k < K; ++k) s += f82f(a[k]) * f82f(b[k]); accs[c] = s; } }
            else { const bf16* a = u.rows ? u.A + (size_t)u.rows[r] * lda : u.A + (size_t)r * lda;
                for (int c = 0; c < BN; ++c) { const bf16* b = u.B + (size_t)c * ldb; float s = 0.f; for (int k = 0; k < K; ++k) s += bf2f(a[k]) * bf2f(b[k]); accs[c] = s; } }
            if constexpr (has_rsc<Epi>::v) { const float rsc = E.rs[(size_t)u.pm * BMR + r]; for (int c = 0; c < BN; ++c) accs[c] *= rsc; }
            if constexpr (has_ssq<Epi>::v) { float q = 0.f;
                if constexpr (Epi::GATED) { for (int j = 0; j < IB; j += 8) q += E.vec8g(u, r, j, accs + j, accs + IB + j); } else { for (int c = 0; c < BN; c += 8) q += E.vec8(u, r, c, accs + c); }
                float* sp = E.ssq + ((size_t)u.pm * BMR + r) * NPS + u.pn * 4; sp[0] = q; sp[1] = sp[2] = sp[3] = 0.f; }
            else if constexpr (Epi::GATED && Epi::PERM) { for (int j = 0; j < IB; j += 8) E.vec8g(u, r, j, accs + j, accs + IB + j); }
            else if constexpr (Epi::GATED) { for (int j = 0; j < IB; j += 4) E.vec4g(u, r, j, accs + j, accs + IB + j); }
            else if constexpr (Epi::PERM) { for (int c = 0; c < BN; c += 8) E.vec8(u, r, c, accs + c); }
            else { for (int c = 0; c < BN; c += 4) E.vec4(u, r, c, accs + c); }
        }
}
#else
namespace pg8 {
typedef short bf16x8 __attribute__((ext_vector_type(8)));
typedef float f32x4 __attribute__((ext_vector_type(4)));
constexpr int BK = 64, HALF = 128, HTB = HALF * BK * 2, STAGE_BYTES = 8 * HTB;
__device__ __forceinline__ int lds_byte(int r, int c) { const int st = (r >> 4) * 2 + (c >> 5), rr = r & 15, cc = c & 31, ob = rr * 64 + cc * 2; return st * 1024 + (ob ^ (((ob >> 9) & 1) << 5)); }
__device__ __forceinline__ void stage_rc(int b, int& R, int& C) { const int st = b / 1024, sb = b % 1024, swz = sb ^ (((sb >> 9) & 1) << 5); R = (st >> 1) * 16 + swz / 64; C = (st & 1) * 32 + (swz % 64) / 2; }

__device__ __forceinline__ int perm32(int rho) { const int n = rho >> 4, i = rho & 15; return 8 * (i >> 2) + 4 * n + (i & 3); }
template <class E, class = void> struct has_rowpre { static constexpr bool v = false; };
template <class E> struct has_rowpre<E, decltype((void)E::ROWPRE)> { static constexpr bool v = true; };
template <class E> struct EpiWrap {
    static constexpr bool PERM = E::PERM;
    E e;
    __device__ __forceinline__ void operator()(const f32x4 (&acc)[2][2][4][2], const GUnit& u, int wr, int wc, int fr, int fq) const {
        int rbase = wr * 64 + fr; asm volatile("" : "+v"(rbase));
        float rsv[8];
        if constexpr (has_rsc<E>::v) {
#pragma unroll
            for (int q = 0; q < 8; ++q) rsv[q] = e.rs[(size_t)u.pm * BMR + (q >> 2) * HALF + (q & 3) * 16 + rbase]; }
        float pre[8];
        if constexpr (has_rowpre<E>::v) {
#pragma unroll
            for (int q = 0; q < 8; ++q) pre[q] = e.rowpre(u, (q >> 2) * HALF + (q & 3) * 16 + rbase); }
        if constexpr (has_hpre<E>::v) {
            constexpr int HB = E::HB; const int c0 = wc * 32 + 8 * fq;
#pragma unroll
            for (int ai = 0; ai < 2; ++ai)
#pragma unroll
                for (int mb = 0; mb < 4; mb += HB) { int r0 = ai * HALF + mb * 16 + rbase; asm volatile("" : "+v"(r0));
                    typename E::Pre px[HB];
#pragma unroll
                    for (int k = 0; k < HB; ++k) px[k] = e.hload(u, r0 + 16 * k, c0);
#pragma unroll
                    for (int k = 0; k < HB; ++k) { const int m = mb + k, r = r0 + 16 * k; float v0[8], v1[8];
#pragma unroll
                        for (int j = 0; j < 4; ++j) { v0[j] = acc[ai][0][m][0][j]; v0[4 + j] = acc[ai][0][m][1][j]; v1[j] = acc[ai][1][m][0][j]; v1[4 + j] = acc[ai][1][m][1][j]; }
                        if constexpr (has_rsc<E>::v) {
#pragma unroll
                            for (int j = 0; j < 8; ++j) { v0[j] *= rsv[ai * 4 + m]; v1[j] *= rsv[ai * 4 + m]; } }
                        float q = e.vec8p(u, r, c0, v0, v1, px[k]);
                        q += __shfl_xor(q, 16); q += __shfl_xor(q, 32);
                        if (fq == 0) e.ssq[((size_t)u.pm * BMR + r) * NPS + u.pn * 4 + wc] = q; }
                    asm volatile("" ::: "memory"); }
            return;
        }
#pragma unroll
        for (int ai = 0; ai < 2; ++ai)
#pragma unroll
            for (int m = 0; m < 4; ++m) { int r = ai * HALF + m * 16 + rbase; asm volatile("" : "+v"(r));
                if constexpr (E::PERM) { const int c0 = wc * 32 + 8 * fq;
                    float v0[8], v1[8];
#pragma unroll
                    for (int j = 0; j < 4; ++j) { v0[j] = acc[ai][0][m][0][j]; v0[4 + j] = acc[ai][0][m][1][j]; v1[j] = acc[ai][1][m][0][j]; v1[4 + j] = acc[ai][1][m][1][j]; }
                    if constexpr (has_rsc<E>::v) {
#pragma unroll
                        for (int j = 0; j < 8; ++j) { v0[j] *= rsv[ai * 4 + m]; v1[j] *= rsv[ai * 4 + m]; } }
                    if constexpr (has_ssq<E>::v) { float q; if constexpr (E::GATED) q = e.vec8g(u, r, c0, v0, v1); else q = e.vec8(u, r, c0, v0) + e.vec8(u, r, HALF + c0, v1);
                        q += __shfl_xor(q, 16); q += __shfl_xor(q, 32);
                        if (fq == 0) e.ssq[((size_t)u.pm * BMR + r) * NPS + u.pn * 4 + wc] = q; }
                    else if constexpr (has_rowpre<E>::v) e.vec8gp(u, r, c0, v0, v1, pre[ai * 4 + m]); else if constexpr (E::GATED) e.vec8g(u, r, c0, v0, v1); else { e.vec8(u, r, c0, v0); e.vec8(u, r, HALF + c0, v1); }
                } else {
#pragma unroll
                    for (int n = 0; n < 2; ++n) { const int c0 = wc * 32 + n * 16 + fq * 4;
                        float v0[4], v1[4];
#pragma unroll
                        for (int j = 0; j < 4; ++j) { v0[j] = acc[ai][0][m][n][j]; v1[j] = acc[ai][1][m][n][j]; }
                        static_assert(!has_rsc<E>::v, "row scale is implemented for PERM epilogues");
                        if constexpr (E::GATED) e.vec4g(u, r, c0, v0, v1); else { e.vec4(u, r, c0, v0); e.vec4(u, r, HALF + c0, v1); } }
                }
                asm volatile("" ::: "memory"); }
    }
};

template <class Epi, class Sched, bool SP2 = true, bool ALIGN_EPI = true, bool F8 = false>
__device__ __forceinline__ void gemm_phase(LAS unsigned char* lds, const int tid, const int lda_b, const int ldb_b, const int K, const Sched& S, const Epi& E) {
    const int wid = __builtin_amdgcn_readfirstlane(tid >> 6), lane = tid & 63, wr = wid >> 2, wc = wid & 3, fr = lane & 15, fq = lane >> 4;
    int nt = F8 ? K / (2 * BK) : K / BK; asm volatile("" : "+s"(nt));
    const int f8one_ = 0x7f;
    unsigned voffB[2];
#pragma unroll
    for (int i = 0; i < 2; ++i) { int R, C; stage_rc(tid * 16 + i * 8192, R, C); const int Rb = Epi::PERM ? ((R & ~31) + perm32(R & 31)) : R; voffB[i] = (unsigned)(Rb * ldb_b + C * 2); }
    const size_t kstep = (size_t)(BK * 2);
    const size_t hstepB = (size_t)HALF * ldb_b;
    const size_t hstepA = Sched::GATHER ? (size_t)0 : (size_t)HALF * lda_b;
    const unsigned ldsw = (unsigned)wid * 1024u;
    const int aoff = lds_byte(wr * 64 + fr, fq * 8), boff = lds_byte(wc * 32 + fr, fq * 8);
#define PG8_SA(b, h) (((b) * 2 + (h)) * HTB)
#define PG8_SB(b, h) ((4 + (b) * 2 + (h)) * HTB)
#define PG8_STAGE(bufoff, gbase, v0, v1) do { \
        __builtin_amdgcn_global_load_lds((const unsigned*)((const char*)(gbase) + (v0)), (LAS unsigned*)(lds + (bufoff) + ldsw), 16, 0, 0); \
        __builtin_amdgcn_global_load_lds((const unsigned*)((const char*)(gbase) + (v1)), (LAS unsigned*)(lds + (bufoff) + ldsw + 8192), 16, 0, 0); } while (0)
#define PG8_LDA(dst, b, h) do { _Pragma("unroll") for (int m = 0; m < 4; ++m) _Pragma("unroll") for (int k = 0; k < 2; ++k) dst[m][k] = *(const LAS bf16x8*)(lds + PG8_SA(b, h) + aoff + m * 2048 + k * 1024); } while (0)
#define PG8_LDB(dst, b, h) do { _Pragma("unroll") for (int n = 0; n < 2; ++n) _Pragma("unroll") for (int k = 0; k < 2; ++k) dst[n][k] = *(const LAS bf16x8*)(lds + PG8_SB(b, h) + boff + n * 2048 + k * 1024); } while (0)
#define PG8_MMA(ai, bj, At, Bt) do { __builtin_amdgcn_s_setprio(1); _Pragma("unroll") for (int m = 0; m < 4; ++m) _Pragma("unroll") for (int n = 0; n < 2; ++n) { \
        if constexpr (F8) { typedef int i32x4_ __attribute__((ext_vector_type(4))); typedef int i32x8_ __attribute__((ext_vector_type(8))); \
            const i32x8_ b8_ = __builtin_shufflevector((i32x4_)Bt[n][0], (i32x4_)Bt[n][1], 0, 1, 2, 3, 4, 5, 6, 7), a8_ = __builtin_shufflevector((i32x4_)At[m][0], (i32x4_)At[m][1], 0, 1, 2, 3, 4, 5, 6, 7); \
            asm volatile("v_mfma_scale_f32_16x16x128_f8f6f4 %0, %1, %2, %0, %3, %3 op_sel_hi:[0,0,0]" : "+v"(acc[ai][bj][m][n]) : "v"(b8_), "v"(a8_), "v"(f8one_)); } \
        else { _Pragma("unroll") for (int k = 0; k < 2; ++k) acc[ai][bj][m][n] = __builtin_amdgcn_mfma_f32_16x16x32_bf16(Bt[n][k], At[m][k], acc[ai][bj][m][n], 0, 0, 0); } } \
        __builtin_amdgcn_s_setprio(0); } while (0)
#define PG8_WAIT_V(n) asm volatile("s_waitcnt vmcnt(" #n ")" ::: "memory")
#define PG8_WAIT_L(n) asm volatile("s_waitcnt lgkmcnt(" #n ")" ::: "memory")
#define PG8_BAR __builtin_amdgcn_s_barrier()
#define PG8_SCHED __builtin_amdgcn_sched_barrier(0)
#define PG8_VOFFA(dst, un) do { _Pragma("unroll") for (int h = 0; h < 2; ++h) _Pragma("unroll") for (int i = 0; i < 2; ++i) { int R_, C_; stage_rc(tid * 16 + i * 8192, R_, C_); \
        int ri = R_; if constexpr (Sched::GATHER) ri = (un).rows[h * HALF + R_]; dst[h][i] = (unsigned)ri * (unsigned)lda_b + (unsigned)(C_ * 2); } } while (0)
    GUnit cur, nxt; int ui = 0;
    if (!S.next(0, cur)) return;
    f32x4 acc[2][2][4][2];
#pragma unroll
    for (int a = 0; a < 2; ++a)
#pragma unroll
        for (int b = 0; b < 2; ++b)
#pragma unroll
            for (int m = 0; m < 4; ++m)
#pragma unroll
                for (int n = 0; n < 2; ++n) acc[a][b][m][n] = (f32x4){0.f, 0.f, 0.f, 0.f};
    bf16x8 At[4][2], B0[2][2], B1[2][2];
    unsigned vA[2][2], nvA[2][2];
    PG8_VOFFA(vA, cur);
    const char* cA = (const char*)cur.A; const char* cB = (const char*)cur.B;
    if constexpr (SP2) {
        PG8_STAGE(PG8_SB(0, 0), cB, voffB[0], voffB[1]); PG8_STAGE(PG8_SB(0, 1), cB + hstepB, voffB[0], voffB[1]); PG8_STAGE(PG8_SA(0, 0), cA, vA[0][0], vA[0][1]); PG8_STAGE(PG8_SA(0, 1), cA + hstepA, vA[1][0], vA[1][1]);
        if (wr == 1) PG8_BAR;
        PG8_WAIT_V(2); PG8_BAR;
        PG8_STAGE(PG8_SB(1, 0), cB + kstep, voffB[0], voffB[1]); PG8_STAGE(PG8_SA(1, 0), cA + kstep, vA[0][0], vA[0][1]); PG8_STAGE(PG8_SB(1, 1), cB + hstepB + kstep, voffB[0], voffB[1]);
        PG8_WAIT_V(6); PG8_BAR;
    } else {
    PG8_STAGE(PG8_SB(0, 0), cB, voffB[0], voffB[1]); PG8_STAGE(PG8_SA(0, 0), cA, vA[0][0], vA[0][1]); PG8_STAGE(PG8_SB(0, 1), cB + hstepB, voffB[0], voffB[1]); PG8_STAGE(PG8_SA(0, 1), cA + hstepA, vA[1][0], vA[1][1]);
    if (wr == 1) PG8_BAR;
    PG8_WAIT_V(4); PG8_BAR;
    PG8_STAGE(PG8_SB(1, 0), cB + kstep, voffB[0], voffB[1]); PG8_STAGE(PG8_SA(1, 0), cA + kstep, vA[0][0], vA[0][1]); PG8_STAGE(PG8_SB(1, 1), cB + hstepB + kstep, voffB[0], voffB[1]);
    PG8_WAIT_V(6); PG8_BAR;
    }
    for (;;) {
        const bool has_next = S.next(ui + 1, nxt);
        if (!has_next) nxt = cur;
        if constexpr (Sched::GATHER) { PG8_VOFFA(nvA, nxt); }
        const char* nA = (const char*)nxt.A; const char* nB = (const char*)nxt.B;
#pragma nounroll
        for (int t = 0; t < nt; t += 2) {
            const bool last = (t == nt - 2);
            const char* a1 = cA + (size_t)(t + 1) * kstep;
            const char* a2 = last ? nA : cA + (size_t)(t + 2) * kstep; const char* b2 = last ? nB : cB + (size_t)(t + 2) * kstep;
            const char* a3 = a2 + kstep; const char* b3 = b2 + kstep;
            unsigned w00 = vA[0][0], w01 = vA[0][1], w10 = vA[1][0], w11 = vA[1][1];
            if constexpr (Sched::GATHER) { if (last) { w00 = nvA[0][0]; w01 = nvA[0][1]; w10 = nvA[1][0]; w11 = nvA[1][1]; } }
            if constexpr (SP2) {
            PG8_LDB(B0, 0, 0); PG8_LDB(B1, 0, 1); PG8_SCHED; PG8_LDA(At, 0, 0); PG8_STAGE(PG8_SA(1, 1), a1 + hstepA, vA[1][0], vA[1][1]);
            PG8_WAIT_V(8); PG8_WAIT_L(0); PG8_BAR; PG8_MMA(0, 0, At, B0); PG8_MMA(0, 1, At, B1); PG8_BAR; PG8_SCHED;
            PG8_LDA(At, 0, 1); PG8_STAGE(PG8_SB(0, 0), b2, voffB[0], voffB[1]); PG8_STAGE(PG8_SB(0, 1), b2 + hstepB, voffB[0], voffB[1]); PG8_STAGE(PG8_SA(0, 0), a2, w00, w01);
            PG8_WAIT_V(8); PG8_WAIT_L(0); PG8_BAR; PG8_MMA(1, 0, At, B0); PG8_MMA(1, 1, At, B1); PG8_BAR; PG8_SCHED;
            PG8_LDB(B0, 1, 0); PG8_LDB(B1, 1, 1); PG8_SCHED; PG8_LDA(At, 1, 0); PG8_STAGE(PG8_SA(0, 1), a2 + hstepA, w10, w11);
            PG8_WAIT_V(8); PG8_WAIT_L(0); PG8_BAR; PG8_MMA(0, 0, At, B0); PG8_MMA(0, 1, At, B1); PG8_BAR; PG8_SCHED;
            PG8_LDA(At, 1, 1); PG8_STAGE(PG8_SB(1, 0), b3, voffB[0], voffB[1]); PG8_STAGE(PG8_SB(1, 1), b3 + hstepB, voffB[0], voffB[1]); PG8_STAGE(PG8_SA(1, 0), a3, w00, w01);
            PG8_WAIT_V(8); PG8_WAIT_L(0); PG8_BAR; PG8_MMA(1, 0, At, B0); PG8_MMA(1, 1, At, B1); PG8_BAR; PG8_SCHED;
            } else {
            PG8_LDB(B0, 0, 0); PG8_SCHED; PG8_LDA(At, 0, 0); PG8_STAGE(PG8_SA(1, 1), a1 + hstepA, vA[1][0], vA[1][1]);
            PG8_WAIT_L(8); PG8_BAR; PG8_WAIT_L(0); PG8_MMA(0, 0, At, B0); PG8_BAR; PG8_SCHED;
            PG8_LDB(B1, 0, 1); PG8_STAGE(PG8_SB(0, 0), b2, voffB[0], voffB[1]);
            PG8_BAR; PG8_WAIT_L(0); PG8_MMA(0, 1, At, B1); PG8_BAR;
            PG8_LDA(At, 0, 1); PG8_STAGE(PG8_SA(0, 0), a2, w00, w01);
            PG8_BAR; PG8_WAIT_L(0); PG8_MMA(1, 0, At, B0); PG8_BAR; PG8_SCHED;
            PG8_STAGE(PG8_SB(0, 1), b2 + hstepB, voffB[0], voffB[1]);
            PG8_WAIT_V(6); PG8_BAR; PG8_MMA(1, 1, At, B1); PG8_BAR;
            PG8_LDB(B0, 1, 0); PG8_SCHED; PG8_LDA(At, 1, 0); PG8_STAGE(PG8_SA(0, 1), a2 + hstepA, w10, w11);
            PG8_WAIT_L(8); PG8_BAR; PG8_WAIT_L(0); PG8_MMA(0, 0, At, B0); PG8_BAR; PG8_SCHED;
            PG8_LDB(B1, 1, 1); PG8_STAGE(PG8_SB(1, 0), b3, voffB[0], voffB[1]);
            PG8_BAR; PG8_WAIT_L(0); PG8_MMA(0, 1, At, B1); PG8_BAR;
            PG8_LDA(At, 1, 1); PG8_STAGE(PG8_SA(1, 0), a3, w00, w01);
            PG8_BAR; PG8_WAIT_L(0); PG8_MMA(1, 0, At, B0); PG8_BAR; PG8_SCHED;
            PG8_STAGE(PG8_SB(1, 1), b3 + hstepB, voffB[0], voffB[1]);
            PG8_WAIT_V(6); PG8_BAR; PG8_MMA(1, 1, At, B1); PG8_BAR;
            }
        }
        if constexpr (F8) { asm volatile("s_nop 7\n\ts_nop 7\n\ts_nop 7" ::: "memory"); }
        if constexpr (ALIGN_EPI) { if (wr == 0) PG8_BAR; }
        E(acc, cur, wr, wc, fr, fq);
        if (!has_next) break;
#pragma unroll
        for (int a = 0; a < 2; ++a)
#pragma unroll
            for (int b = 0; b < 2; ++b)
#pragma unroll
                for (int m = 0; m < 4; ++m)
#pragma unroll
                    for (int n = 0; n < 2; ++n) acc[a][b][m][n] = (f32x4){0.f, 0.f, 0.f, 0.f};
        cur = nxt; cA = nA; cB = nB; ++ui;
        if constexpr (Sched::GATHER) {
#pragma unroll
            for (int h = 0; h < 2; ++h)
#pragma unroll
                for (int i = 0; i < 2; ++i) vA[h][i] = nvA[h][i]; }
        if constexpr (ALIGN_EPI) { if (wr == 1) PG8_BAR; }
    }
    PG8_WAIT_V(0);
    if constexpr (!ALIGN_EPI) { if (wr == 0) PG8_BAR; }
    PG8_BAR;
#undef PG8_SA
#undef PG8_SB
#undef PG8_STAGE
#undef PG8_LDA
#undef PG8_LDB
#undef PG8_MMA
#undef PG8_WAIT_V
#undef PG8_WAIT_L
#undef PG8_BAR
#undef PG8_SCHED
#undef PG8_VOFFA
}
}
template <bool F8 = false, class Epi, class Sched> __device__ __forceinline__ void gemm_run(const Ctx& cx, int lda, int ldb, int K, const Sched& Sc, const Epi& E) {
    pg8::EpiWrap<Epi> W{E};
    pg8::gemm_phase<pg8::EpiWrap<Epi>, Sched, true, true, F8>(cx.lds, cx.tid, F8 ? lda : lda * 2, F8 ? ldb : ldb * 2, K, Sc, W);
    __syncthreads();
}
#endif

HD int prep_col(int np, int Nsrc, int mode, int HW) {
    if (mode == 0) return np < Nsrc ? np : -1;
    const int t = np / (2 * IB), w = np % (2 * IB); return (w / IB) * HW + t * IB + (w % IB);
}
DEV void prep_transpose_multi(const Ctx& cx, const float* src, size_t src_ms, int nmat, int K, int Nsrc, bf16* dst, size_t dst_ms, int Np, int mode, int HW, float f8scale, const float* ksc = nullptr) {
    constexpr int NTI = 3, TS = PT_K * 64, NLD = (PT_K * 16 * NTI + NT - 1) / NT; static_assert(2 * NTI * TS * 4 <= 131072, "LDS budget of the phase scratch region");
    const int nkb = K / PT_K, nnb = Np / 64, npm = nkb * nnb, nit = npm * nmat;
    const int nset = (nit + cx.nblk * NTI - 1) / (cx.nblk * NTI);
    for (int st = 0; st <= nset; ++st) {
        const int itl = (st * cx.nblk + cx.bid) * NTI, its = ((st - 1) * cx.nblk + cx.bid) * NTI;
        const int bl = (st & 1) * NTI * TS, bs = ((st - 1) & 1) * NTI * TS;
        FOR_THREADS(t) {
            F4 v[NLD];
            for (int j = 0; j < NLD; ++j) { const int e = t + j * NT, q = e / (PT_K * 16), ee = e % (PT_K * 16), it = itl + q; v[j].x = v[j].y = v[j].z = v[j].w = 0.f;
                if (st < nset && q < NTI && it < nit) { const int mi = it / npm, ir = it % npm; const int k0 = (ir / nnb) * PT_K, n0 = (ir % nnb) * 64, kk = ee / 16, n4 = (ee % 16) * 4, col = prep_col(n0 + n4, Nsrc, mode, HW);
                    if (col >= 0) v[j] = *(const F4*)(src + (size_t)mi * src_ms + (size_t)(k0 + kk) * Nsrc + col); } }
            if (st > 0) { for (int q = 0; q < NTI; ++q) { const int it = its + q; if (it < nit) { const int mi = it / npm, ir = it % npm; const int k0 = (ir / nnb) * PT_K, n0 = (ir % nnb) * 64; unsigned char* dm = (unsigned char*)dst + (size_t)mi * dst_ms;
                for (int e = t; e < 64 * (PT_K / 8); e += NT) { const int nn = e / (PT_K / 8), k8 = (e % (PT_K / 8)) * 8; const int lb = bs + q * TS; float x[8];
#pragma unroll
                    for (int i = 0; i < 8; ++i) x[i] = LDSP(float, 0)[lb + (k8 + i) * 64 + (nn ^ k8)];
                    if (f8scale != 0.f) { U2 w8; w8.x = pk4_f8(x[0] * f8scale, x[1] * f8scale, x[2] * f8scale, x[3] * f8scale); w8.y = pk4_f8(x[4] * f8scale, x[5] * f8scale, x[6] * f8scale, x[7] * f8scale);
                        *(U2*)(dm + (size_t)(n0 + nn) * K + k0 + k8) = w8; }
                    else { if (ksc) { const F4 g0 = *(const F4*)(ksc + k0 + k8), g1 = *(const F4*)(ksc + k0 + k8 + 4); x[0] *= g0.x; x[1] *= g0.y; x[2] *= g0.z; x[3] *= g0.w; x[4] *= g1.x; x[5] *= g1.y; x[6] *= g1.z; x[7] *= g1.w; }
                        U4 w; w.x = pk2(x[0], x[1]); w.y = pk2(x[2], x[3]); w.z = pk2(x[4], x[5]); w.w = pk2(x[6], x[7]); *(U4*)(dm + ((size_t)(n0 + nn) * K + k0 + k8) * 2) = w; } } } } }
            for (int j = 0; j < NLD; ++j) { const int e = t + j * NT, q = e / (PT_K * 16), ee = e % (PT_K * 16);
                if (st < nset && q < NTI) { const int kk = ee / 16, n4 = (ee % 16) * 4; float* l = (float*)&LDSP(float, 0)[bl + q * TS + kk * 64 + (n4 ^ (kk & ~7))]; l[0] = v[j].x; l[1] = v[j].y; l[2] = v[j].z; l[3] = v[j].w; } }
        }
        BLOCK_SYNC();
    }
}
DEV void prep_transpose(const Ctx& cx, const float* src, int K, int Nsrc, bf16* dst, int Np, int mode, int HW, float f8scale = 0.f, const float* ksc = nullptr) {
    prep_transpose_multi(cx, src, 0, 1, K, Nsrc, dst, 0, Np, mode, HW, f8scale, ksc);
}
DEV void stage_norm(const Ctx& cx, const float* Xin, const bf16* Hin, bf16* Hcopy, const float* gain, bf16* XNo,
                    const bf16* Ymoe, const int* SLOTi, const float* TOPWi,
                    const float* router, int* TOPIo, float* TOPWo, int* CNTo, float* RINVo = nullptr, fp8* XN8o = nullptr) {
    constexpr int NC = D / 4, NS = LANE_SLOTS(NC) > 0 ? LANE_SLOTS(NC) : 1, NRW = 2;
    static_assert((NC % 64 == 0 || NC < 64) && T % NRW == 0, "row chunking");
    if (router) { FOR_THREADS(t) { if (t < NE) LDSP(int, 0)[t] = 0; } BLOCK_SYNC(); }
    ROW_FOR(rp, T / NRW) {
        F4 hv[NRW][NS]; float ss[NRW];
#pragma unroll
        for (int k = 0; k < NRW; ++k) { const size_t r = (size_t)rp * NRW + k; ss[k] = 0.f;
            int s0 = 0, s1 = 0; float w0 = 0.f, w1 = 0.f;
            if (Ymoe) { s0 = SLOTi[r * 2]; s1 = SLOTi[r * 2 + 1]; w0 = TOPWi[r * 2]; w1 = TOPWi[r * 2 + 1]; }
            LANE_FOR_S(sl, c, NC) { F4 v;
                if (Xin) v = *(const F4*)(Xin + r * D + 4 * c);
                else { const U2 hw = *(const U2*)(Hin + r * D + 4 * c); v.x = bf2f((bf16)(hw.x & 0xffffu)); v.y = bf2f((bf16)(hw.x >> 16)); v.z = bf2f((bf16)(hw.y & 0xffffu)); v.w = bf2f((bf16)(hw.y >> 16)); }
                if (Ymoe) { const U2 a = *(const U2*)(Ymoe + (size_t)s0 * D + 4 * c), b2 = *(const U2*)(Ymoe + (size_t)s1 * D + 4 * c);
                    v.x += w0 * bf2f((bf16)(a.x & 0xffffu)) + w1 * bf2f((bf16)(b2.x & 0xffffu)); v.y += w0 * bf2f((bf16)(a.x >> 16)) + w1 * bf2f((bf16)(b2.x >> 16));
                    v.z += w0 * bf2f((bf16)(a.y & 0xffffu)) + w1 * bf2f((bf16)(b2.y & 0xffffu)); v.w += w0 * bf2f((bf16)(a.y >> 16)) + w1 * bf2f((bf16)(b2.y >> 16)); }
                hv[k][sl] = v; ss[k] += (v.x * v.x + v.y * v.y) + (v.z * v.z + v.w * v.w); } }
#pragma unroll
        for (int k = 0; k < NRW; ++k) { const size_t r = (size_t)rp * NRW + k;
            if (Hcopy) { LANE_FOR_S(sl, c, NC) { U2 hw; hw.x = pk2(hv[k][sl].x, hv[k][sl].y); hw.y = pk2(hv[k][sl].z, hv[k][sl].w); *(U2*)(Hcopy + r * D + 4 * c) = hw; } }
            ss[k] = WAVE_SUM(ss[k]); }
#pragma unroll
        for (int k = 0; k < NRW; ++k) { const size_t r = (size_t)rp * NRW + k;
            const float rinv = 1.0f / sqrtf(ss[k] * (1.0f / D) + NORM_EPS);
            if (RINVo) { if (LANE0) RINVo[r] = rinv; }
            if (!XNo && !router && !XN8o) continue;
            float lg[NE];
#pragma unroll
            for (int e = 0; e < NE; ++e) lg[e] = 0.f;
            LANE_FOR_S(sl, c, NC) { const F4 g4 = *(const F4*)(gain + 4 * c); const F4 v = hv[k][sl];
                const float x0 = v.x * rinv * g4.x, x1 = v.y * rinv * g4.y, x2 = v.z * rinv * g4.z, x3 = v.w * rinv * g4.w;
                if (XNo) { U2 o; o.x = pk2(x0, x1); o.y = pk2(x2, x3); *(U2*)(XNo + r * D + 4 * c) = o; }
                if (XN8o) *(unsigned*)(XN8o + r * D + 4 * c) = pk4_f8(x0 * F8S_X, x1 * F8S_X, x2 * F8S_X, x3 * F8S_X);
                if (router) { const float* rp2 = router + (size_t)(4 * c) * NE;
#pragma unroll
                    for (int e = 0; e < NE; ++e) lg[e] += x0 * rp2[e] + x1 * rp2[NE + e] + x2 * rp2[2 * NE + e] + x3 * rp2[3 * NE + e]; } }
            if (router) {
#pragma unroll
                for (int e = 0; e < NE; ++e) lg[e] = WAVE_SUM(lg[e]);
                int i0 = 0; float b0 = lg[0];
#pragma unroll
                for (int e = 1; e < NE; ++e) if (lg[e] > b0) { b0 = lg[e]; i0 = e; }
                int i1 = -1; float b1 = -INFINITY;
#pragma unroll
                for (int e = 0; e < NE; ++e) if (e != i0 && lg[e] > b1) { b1 = lg[e]; i1 = e; }
                const float wa = 1.0f / (1.0f + expf(b1 - b0));
                if (LANE0) { TOPIo[r * 2] = i0; TOPIo[r * 2 + 1] = i1; TOPWo[r * 2] = wa; TOPWo[r * 2 + 1] = 1.0f - wa; LDS_ATOMIC_ADD(&LDSP(int, 0)[i0], 1); LDS_ATOMIC_ADD(&LDSP(int, 0)[i1], 1); }
            } }
    }
    if (router) { BLOCK_SYNC(); FOR_THREADS(t) { if (t < NE) ATOMIC_ADD(&CNTo[t], LDSP(int, 0)[t]); } BLOCK_SYNC(); }
}
DEV void stage_rinv(const Ctx& cx, const float* SSQi, int np, float* RINVo) {
    GRID_FOR(r, T) { float q = 0.f; for (int i = 0; i < np; i += 4) { const F4 v = *(const F4*)(SSQi + (size_t)r * NPS + i); q += (v.x + v.y) + (v.z + v.w); }
        RINVo[r] = 1.0f / sqrtf(q * (1.0f / D) + NORM_EPS); }
}
DEV void stage_p2b(const Ctx& cx, const float* p, bf16* PBo) {
    constexpr size_t NI = (size_t)T * PLE / 8; constexpr int UB = 4;
#ifdef HOST_SIM
    GRID_FOR(i, NI) { const F4 a = *(const F4*)(p + 8 * i), b2 = *(const F4*)(p + 8 * i + 4); U4 w; w.x = pk2(a.x, a.y); w.y = pk2(a.z, a.w); w.z = pk2(b2.x, b2.y); w.w = pk2(b2.z, b2.w); *(U4*)(PBo + 8 * i) = w; }
#else
    const size_t stride = (size_t)cx.nblk * NT;
    for (size_t i0 = (size_t)cx.bid * NT + cx.tid; i0 < NI; i0 += stride * UB) { F4 a[UB], b2[UB];
#pragma unroll
        for (int q = 0; q < UB; ++q) { const size_t i = i0 + q * stride; if (i < NI) { a[q] = *(const F4*)(p + 8 * i); b2[q] = *(const F4*)(p + 8 * i + 4); } }
#pragma unroll
        for (int q = 0; q < UB; ++q) { const size_t i = i0 + q * stride; if (i < NI) { U4 w; w.x = pk2(a[q].x, a[q].y); w.y = pk2(a[q].z, a[q].w); w.z = pk2(b2[q].x, b2[q].y); w.w = pk2(b2[q].z, b2[q].w); *(U4*)(PBo + 8 * i) = w; } } }
#endif
}
DEV void stage_moe_assign(const Ctx& cx, const int* TOPI_, int* SLOT_, const bf16* XN_, bf16* XNP, const int* CNT_, int* CNT2_) {
    const int ntok = T / cx.nblk;
    constexpr int L_CNT = 0, L_BASE = 64, L_RUN = 128, L_SLOT = 256;
    FOR_THREADS(t) { if (t < NE) { LDSP(int, L_CNT)[t] = 0; LDSP(int, L_RUN)[t] = 0; } }
    BLOCK_SYNC();
    FOR_THREADS(t) { for (int idx = t; idx < ntok * 2; idx += NT) { const int tok = cx.bid + (idx >> 1) * cx.nblk; LDS_ATOMIC_ADD(&LDSP(int, L_CNT)[TOPI_[tok * 2 + (idx & 1)]], 1); } }
    BLOCK_SYNC();
    FOR_THREADS(t) { if (t < NE) { int bs = 0;
#pragma unroll
        for (int k = 0; k < NE; ++k) if (k < t) bs += ((CNT_[k] + BMR - 1) / BMR) * BMR;
        LDSP(int, L_BASE)[t] = bs + ATOMIC_ADD(&CNT2_[t], LDSP(int, L_CNT)[t]); } }
    BLOCK_SYNC();
    FOR_THREADS(t) { for (int idx = t; idx < ntok * 2; idx += NT) { const int tok = cx.bid + (idx >> 1) * cx.nblk, e = TOPI_[tok * 2 + (idx & 1)];
        const int slot = LDSP(int, L_BASE)[e] + LDS_ATOMIC_ADD(&LDSP(int, L_RUN)[e], 1); SLOT_[tok * 2 + (idx & 1)] = slot; LDSP(int, L_SLOT)[idx] = slot; } }
    BLOCK_SYNC();
    FOR_THREADS(t) { constexpr int UB = 4; const int nchunk = ntok * 2 * (D / 8);
        for (int idx0 = t; idx0 < nchunk; idx0 += NT * UB) { U4 vv[UB]; int sl[UB];
#pragma unroll
            for (int q = 0; q < UB; ++q) { const int idx = idx0 + q * NT; if (idx < nchunk) { const int rowi = idx / (D / 8), ch = idx % (D / 8); const int tok = cx.bid + (rowi >> 1) * cx.nblk;
                vv[q] = *(const U4*)(XN_ + (size_t)tok * D + ch * 8); sl[q] = LDSP(int, L_SLOT)[rowi]; } }
#pragma unroll
            for (int q = 0; q < UB; ++q) { const int idx = idx0 + q * NT; if (idx < nchunk) { const int ch = idx % (D / 8); const unsigned w[4] = {vv[q].x, vv[q].y, vv[q].z, vv[q].w}; float x[8];
#pragma unroll
                for (int e = 0; e < 8; ++e) x[e] = bf2f((bf16)((e & 1) ? (w[e >> 1] >> 16) : (w[e >> 1] & 0xffffu))) * F8S_X;
                U2 o; o.x = pk4_f8(x[0], x[1], x[2], x[3]); o.y = pk4_f8(x[4], x[5], x[6], x[7]);
                *(U2*)((fp8*)XNP + (size_t)sl[q] * D + ch * 8) = o; } } } }
    BLOCK_SYNC();
}
DEV void stage_transpose_cols(const Ctx& cx, const bf16* src, int ld, int col0, int ncols, bf16* dst) {
    const int cw = (ncols % 64 == 0) ? 64 : 32, nct = ncols / cw, nst = S / 64, nit = NB * nst * nct;
    for (int it = cx.bid; it < nit; it += cx.nblk) {
        const int ct = it % nct, st = (it / nct) % nst, b = it / (nct * nst);
        FOR_THREADS(t) { for (int e = t; e < 64 * (cw / 8); e += NT) { const int ss = e / (cw / 8), c8 = (e % (cw / 8)) * 8;
            const U4 v = *(const U4*)(src + ((size_t)b * S + st * 64 + ss) * ld + col0 + ct * cw + c8); const unsigned w[4] = {v.x, v.y, v.z, v.w};
            for (int i = 0; i < 4; ++i) { LDSP(bf16, 0)[(c8 + 2 * i) * 72 + ss] = (bf16)(w[i] & 0xffffu); LDSP(bf16, 0)[(c8 + 2 * i + 1) * 72 + ss] = (bf16)(w[i] >> 16); } } }
        BLOCK_SYNC();
        FOR_THREADS(t) { for (int e = t; e < cw * 8; e += NT) { const int cc = e / 8, s8 = (e % 8) * 8;
            const U4 v = *(const U4*)&LDSP(bf16, 0)[cc * 72 + s8];
            *(U4*)(dst + ((size_t)b * ncols + ct * cw + cc) * S + st * 64 + s8) = v; } }
        BLOCK_SYNC();
    }
}
DEV void stage_transpose_cols2(const Ctx& cx, const bf16* src, int ld, int col0a, int col0b, int ncols, bf16* dsta, bf16* dstb) {
    constexpr int UB = 4, TSZ = 64 * 72;
    const int cw = (ncols % 64 == 0) ? 64 : 32, nct = ncols / cw, nst = S / 64, nit1 = NB * nst * nct, nit = 2 * nit1;
    for (int it0 = cx.bid; it0 < nit; it0 += UB * cx.nblk) {
        FOR_THREADS(t) { for (int e = t; e < 64 * (cw / 8); e += NT) { const int ss = e / (cw / 8), c8 = (e % (cw / 8)) * 8; U4 v[UB];
#pragma unroll
            for (int u = 0; u < UB; ++u) { const int it = it0 + u * cx.nblk; if (it < nit) { const int r = it % nit1, ct = r % nct, st = (r / nct) % nst, b = r / (nct * nst);
                v[u] = *(const U4*)(src + ((size_t)b * S + st * 64 + ss) * ld + (it < nit1 ? col0a : col0b) + ct * cw + c8); } }
#pragma unroll
            for (int u = 0; u < UB; ++u) { const int it = it0 + u * cx.nblk; if (it < nit) { const unsigned w[4] = {v[u].x, v[u].y, v[u].z, v[u].w};
                for (int i = 0; i < 4; ++i) { LDSP(bf16, 0)[u * TSZ + (c8 + 2 * i) * 72 + ss] = (bf16)(w[i] & 0xffffu); LDSP(bf16, 0)[u * TSZ + (c8 + 2 * i + 1) * 72 + ss] = (bf16)(w[i] >> 16); } } } } }
        BLOCK_SYNC();
        FOR_THREADS(t) { for (int e = t; e < cw * 8; e += NT) { const int cc = e / 8, s8 = (e % 8) * 8;
#pragma unroll
            for (int u = 0; u < UB; ++u) { const int it = it0 + u * cx.nblk; if (it < nit) { const int r = it % nit1, ct = r % nct, st = (r / nct) % nst, b = r / (nct * nst);
                const U4 vv = *(const U4*)&LDSP(bf16, 0)[u * TSZ + cc * 72 + s8];
                *(U4*)((it < nit1 ? dsta : dstb) + ((size_t)b * ncols + ct * cw + cc) * S + st * 64 + s8) = vv; } } } }
        BLOCK_SYNC();
    }
}
constexpr int VSW = RDV < 64 ? RDV : 64;
DEV void stage_ret_core(const Ctx& cx, const bf16* RAW, const bf16* KT, const bf16* VT, bf16* O) {
    constexpr int NVS = RDV / VSW, NU = NB * RH * NVS, NCH = S / RC;
    constexpr int L_R = 0, L_S = RDK * VSW * 4, L_O = L_S + RC * RC * 4;
    for (int un = cx.bid; un < NU; un += cx.nblk) {
        const int vs = un % NVS, h = (un / NVS) % RH, b = un / (NVS * RH);
        const float lg2h = log2_gamma_(h), cd = fexp2_((float)RC * lg2h);
        FOR_THREADS(t) { for (int e = t; e < RDK * VSW; e += NT) LDSP(float, L_R)[e] = 0.f; }
        BLOCK_SYNC();
        for (int n = 0; n < NCH; ++n) {
            const size_t r0 = (size_t)b * S + (size_t)n * RC;
            const bf16* Qb = RAW + r0 * RIN + h * RDK; const bf16* Kb = RAW + r0 * RIN + RH * RDK + h * RDK;
            const bf16* KTb = KT + ((size_t)b * RH * RDK + h * RDK) * S + n * RC; const bf16* Vb = RAW + r0 * RIN + 2 * RH * RDK + h * RDV + vs * VSW;
            FOR_THREADS(t) { for (int e = t; e < RC * RC; e += NT) { const int i = e / RC, j = e % RC; float sc = 0.f;
                if (j <= i) { const bf16* qp = Qb + (size_t)i * RIN; const bf16* kp = Kb + (size_t)j * RIN; for (int d = 0; d < RDK; ++d) sc += bf2f(qp[d]) * bf2f(kp[d]); sc /= cd; }
                LDSP(float, L_S)[e] = sc; } }
            BLOCK_SYNC();
            FOR_THREADS(t) { for (int e = t; e < RC * VSW; e += NT) { const int i = e / VSW, v = e % VSW; float a = 0.f;
                for (int j = 0; j <= i; ++j) a += LDSP(float, L_S)[i * RC + j] * bf2f(Vb[(size_t)j * RIN + v]);
                const bf16* qp = Qb + (size_t)i * RIN; for (int d = 0; d < RDK; ++d) a += bf2f(qp[d]) * LDSP(float, L_R)[d * VSW + v];
                LDSP(float, L_O)[e] = a * fexp2_((float)(i + 1) * lg2h); } }
            BLOCK_SYNC();
            FOR_THREADS(t) { for (int e = t; e < RDK * VSW; e += NT) { const int d = e / VSW, v = e % VSW; float a = 0.f;
                for (int j = 0; j < RC; ++j) a += bf2f(Kb[(size_t)j * RIN + d]) * bf2f(Vb[(size_t)j * RIN + v]);
                LDSP(float, L_R)[e] = LDSP(float, L_R)[e] * cd + a; } }
            BLOCK_SYNC();
            FOR_THREADS(t) { for (int e = t; e < RC * VSW; e += NT) { const int i = e / VSW, v = e % VSW; O[(r0 + i) * RIN + h * RDV + vs * VSW + v] = f2bf(LDSP(float, L_O)[e]); } }
            BLOCK_SYNC();
        }
    }
}
DEV void stage_ret_norm(const Ctx& cx, const bf16* O, const bf16* RAW, const float* gn, bf16* ON) {
    constexpr int NC = RDV / 8, NS = LANE_SLOTS(NC) > 0 ? LANE_SLOTS(NC) : 1;
    ROW_FOR(r, T) {
        U4 oa[RH][NS], ga[RH][NS];
#pragma unroll
        for (int h = 0; h < RH; ++h) { const bf16* op = O + (size_t)r * RIN + h * RDV; const bf16* gp = RAW + (size_t)r * RIN + 2 * RH * RDK + RH * RDV + h * RDV;
            LANE_FOR_S(sl, c, NC) { oa[h][sl] = *(const U4*)(op + 8 * c); ga[h][sl] = *(const U4*)(gp + 8 * c); } }
#pragma unroll
        for (int h = 0; h < RH; ++h) { bf16* onp = ON + (size_t)r * RVW + h * RDV;
            float ov[NS * 8], gv[NS * 8]; float s1 = 0.f;
            LANE_FOR_S(sl, c, NC) { const unsigned aw[4] = {oa[h][sl].x, oa[h][sl].y, oa[h][sl].z, oa[h][sl].w}, gw[4] = {ga[h][sl].x, ga[h][sl].y, ga[h][sl].z, ga[h][sl].w};
#pragma unroll
                for (int i = 0; i < 4; ++i) { ov[sl * 8 + 2 * i] = bf2f((bf16)(aw[i] & 0xffffu)); ov[sl * 8 + 2 * i + 1] = bf2f((bf16)(aw[i] >> 16)); gv[sl * 8 + 2 * i] = bf2f((bf16)(gw[i] & 0xffffu)); gv[sl * 8 + 2 * i + 1] = bf2f((bf16)(gw[i] >> 16)); }
#pragma unroll
                for (int i = 0; i < 8; ++i) s1 += ov[sl * 8 + i]; }
            s1 = WAVE_SUM(s1); const float mu = s1 * (1.0f / RDV); float s2 = 0.f;
            LANE_FOR_S(sl, c, NC) {
#pragma unroll
                for (int i = 0; i < 8; ++i) { const float d = ov[sl * 8 + i] - mu; s2 += d * d; } }
            s2 = WAVE_SUM(s2); const float rstd = 1.0f / sqrtf(s2 * (1.0f / RDV) + NORM_EPS);
            LANE_FOR_S(sl, c, NC) { float o[8];
#pragma unroll
                for (int i = 0; i < 8; ++i) o[i] = (ov[sl * 8 + i] - mu) * rstd * gn[h * RDV + 8 * c + i] * siluf_(gv[sl * 8 + i]);
                U4 w; w.x = pk2(o[0], o[1]); w.y = pk2(o[2], o[3]); w.z = pk2(o[4], o[5]); w.w = pk2(o[6], o[7]); *(U4*)(onp + 8 * c) = w; } }
    }
}
DEV void stage_s5_prep(const Ctx& cx, const float* a_re, const float* a_im, const float* b_re, const float* b_im, const float* log_dt, float* AB, float* BB) {
    GRID_FOR(i, SG * SP) {
        const int g = (int)(i / SP); const float dt = expf(log_dt[g]), ar = a_re[i], ai = a_im[i];
        const float mag = expf(dt * ar), abr = mag * cosf(dt * ai), abi = mag * sinf(dt * ai), den = ar * ar + ai * ai, nr = abr - 1.0f, ni = abi;
        const float fre = (nr * ar + ni * ai) / den, fim = (ni * ar - nr * ai) / den;
        float pr = abr, pi = abi;
        for (int k = 1; k < S / (NT / SP); k <<= 1) { const float n1 = pr * pr - pi * pi, n2 = 2.f * pr * pi; pr = n1; pi = n2; }
        AB[i * 4] = abr; AB[i * 4 + 1] = abi; AB[i * 4 + 2] = pr; AB[i * 4 + 3] = pi;
        for (int c = 0; c < SGC; ++c) { const float br = b_re[i * SGC + c], bi = b_im[i * SGC + c]; BB[(i * SGC + c) * 2] = fre * br - fim * bi; BB[(i * SGC + c) * 2 + 1] = fre * bi + fim * br; }
    }
}
DEV void stage_s5_core(const Ctx& cx, const bf16* U, bf16* Y, const float* AB, const float* BB, const float* c_re, const float* c_im, const float* dskip) {
    constexpr int NSEG = NT / SP, SEGL = S / NSEG, MC = 8, XBS = SP * 2 + 2, CS = SP + 1;
    constexpr int L_U = 0, L_CR = L_U + S * SGC * 2, L_CI = L_CR + SGC * CS * 4, L_XEND = L_CI + SGC * CS * 4, L_XIN = L_XEND + NSEG * SP * 2 * 4, L_ST = L_XIN + NSEG * SP * 2 * 4, L_XB = L_ST + NSEG * SP * 2 * 4,
                  L_END = L_XB + NSEG * MC * XBS * 4;
    static_assert(SP == 64 && NSEG == 8 && SEGL % MC == 0 && (SEGL & (SEGL - 1)) == 0 && SGC == 16 && L_END <= 131072, "s5 geometry");
    for (int un = cx.bid; un < NB * SG; un += cx.nblk) {
        const int g = un % SG, b = un / SG;
        FOR_THREADS(t) {
            for (int e = t; e < S * 2; e += NT) { const int sx = e >> 1, hf = e & 1; *(U4*)&LDSP(bf16, L_U)[sx * SGC + hf * 8] = *(const U4*)(U + ((size_t)b * S + sx) * D + g * SGC + hf * 8); }
            for (int e = t; e < SGC * SP; e += NT) { const int c = e / SP, p = e % SP; LDSP(float, L_CR)[c * CS + p] = c_re[((size_t)g * SGC + c) * SP + p]; LDSP(float, L_CI)[c * CS + p] = c_im[((size_t)g * SGC + c) * SP + p]; } }
        BLOCK_SYNC();
        FOR_THREADS(t) { const int w = t / SP, p = t % SP; const float abr = AB[(g * SP + p) * 4], abi = AB[(g * SP + p) * 4 + 1];
            float br[SGC], bi[SGC];
_Pragma("unroll") for (int c = 0; c < SGC; ++c) { br[c] = BB[((g * SP + p) * SGC + c) * 2]; bi[c] = BB[((g * SP + p) * SGC + c) * 2 + 1]; }
            float xr = 0.f, xi = 0.f;
            for (int sx = w * SEGL; sx < (w + 1) * SEGL; ++sx) { const U4 u0 = *(const U4*)&LDSP(bf16, L_U)[sx * SGC], u1 = *(const U4*)&LDSP(bf16, L_U)[sx * SGC + 8]; const unsigned uw[8] = {u0.x, u0.y, u0.z, u0.w, u1.x, u1.y, u1.z, u1.w};
                float ur = 0.f, ui = 0.f;
_Pragma("unroll") for (int c = 0; c < SGC; ++c) { const float uv = bf2f((bf16)((c & 1) ? (uw[c >> 1] >> 16) : (uw[c >> 1] & 0xffffu))); ur += br[c] * uv; ui += bi[c] * uv; }
                const float nr = abr * xr - abi * xi + ur, ni = abr * xi + abi * xr + ui; xr = nr; xi = ni; }
            LDSP(float, L_XEND)[(w * SP + p) * 2] = xr; LDSP(float, L_XEND)[(w * SP + p) * 2 + 1] = xi; }
        BLOCK_SYNC();
        FOR_THREADS(t) { if (t < SP) { const int p = t; const float pr = AB[(g * SP + p) * 4 + 2], pi = AB[(g * SP + p) * 4 + 3];
            float xr = 0.f, xi = 0.f;
            for (int w = 0; w < NSEG; ++w) { LDSP(float, L_XIN)[(w * SP + p) * 2] = xr; LDSP(float, L_XIN)[(w * SP + p) * 2 + 1] = xi;
                const float er = LDSP(float, L_XEND)[(w * SP + p) * 2], ei = LDSP(float, L_XEND)[(w * SP + p) * 2 + 1];
                const float nr = pr * xr - pi * xi + er, ni = pr * xi + pi * xr + ei; xr = nr; xi = ni; } } }
        BLOCK_SYNC();
        for (int mc = 0; mc < SEGL / MC; ++mc) {
            FOR_THREADS(t) { const int w = t / SP, p = t % SP; const float abr = AB[(g * SP + p) * 4], abi = AB[(g * SP + p) * 4 + 1];
                float br[SGC], bi[SGC];
_Pragma("unroll") for (int c = 0; c < SGC; ++c) { br[c] = BB[((g * SP + p) * SGC + c) * 2]; bi[c] = BB[((g * SP + p) * SGC + c) * 2 + 1]; }
                const int so = (mc == 0) ? L_XIN : L_ST; float xr = LDSP(float, so)[(w * SP + p) * 2], xi = LDSP(float, so)[(w * SP + p) * 2 + 1];
                for (int i = 0; i < MC; ++i) { const int sx = w * SEGL + mc * MC + i; const U4 u0 = *(const U4*)&LDSP(bf16, L_U)[sx * SGC], u1 = *(const U4*)&LDSP(bf16, L_U)[sx * SGC + 8]; const unsigned uw[8] = {u0.x, u0.y, u0.z, u0.w, u1.x, u1.y, u1.z, u1.w};
                    float ur = 0.f, ui = 0.f;
_Pragma("unroll") for (int c = 0; c < SGC; ++c) { const float uv = bf2f((bf16)((c & 1) ? (uw[c >> 1] >> 16) : (uw[c >> 1] & 0xffffu))); ur += br[c] * uv; ui += bi[c] * uv; }
                    const float nr = abr * xr - abi * xi + ur, ni = abr * xi + abi * xr + ui; xr = nr; xi = ni;
                    LDSP(float, L_XB)[(w * MC + i) * XBS + p * 2] = xr; LDSP(float, L_XB)[(w * MC + i) * XBS + p * 2 + 1] = xi; }
                LDSP(float, L_ST)[(w * SP + p) * 2] = xr; LDSP(float, L_ST)[(w * SP + p) * 2 + 1] = xi; }
            BLOCK_SYNC();
            FOR_THREADS(t) { const int w = t / 64, l = t % 64;
                for (int e = l; e < MC * SGC; e += 64) { const int i = e / SGC, c = e % SGC; float y = 0.f;
                    for (int p = 0; p < SP; ++p) y += LDSP(float, L_CR)[c * CS + p] * LDSP(float, L_XB)[(w * MC + i) * XBS + p * 2] - LDSP(float, L_CI)[c * CS + p] * LDSP(float, L_XB)[(w * MC + i) * XBS + p * 2 + 1];
                    const int sx = w * SEGL + mc * MC + i; const size_t r = (size_t)b * S + sx; y += dskip[g * SGC + c] * bf2f(LDSP(bf16, L_U)[sx * SGC + c]); Y[r * D + g * SGC + c] = f2bf(geluf_(y)); } }
            BLOCK_SYNC();
        }
    }
}
DEV void stage_nsa_prep1(const Ctx& cx, const bf16* RAW, const int* pos, const float* qn, const float* kn, bf16* QN, bf16* KS, bf16* VS, bf16* KW, bf16* VW, bf16* KCR, bf16* VCR, float* GT) {
    constexpr int NTASK = NH + 6 * NG;
    ROW_FOR(q, (size_t)T * NTASK) {
        const size_t r = q / NTASK; const int k = (int)(q % NTASK); const int b = (int)(r / S), s = (int)(r % S);
        const bf16* src; bf16* dst; const float* gain = nullptr;
        if (k < NH) { src = RAW + r * NSA_INP + k * NDH; dst = QN + r * D + k * NDH; gain = qn; }
        else { const int kk = (k - NH) / NG, g = (k - NH) % NG;
            const int colo = kk == 0 ? D + 2 * KVW : kk == 1 ? D + 4 * KVW : kk == 2 ? D + 3 * KVW : kk == 3 ? D + 5 * KVW : kk == 4 ? D : D + KVW;
            bf16* const dstb = kk == 0 ? KS : kk == 1 ? KW : kk == 2 ? VS : kk == 3 ? VW : kk == 4 ? KCR : VCR;
            src = RAW + r * NSA_INP + colo + g * NDH; dst = dstb + (((size_t)b * NG + g) * S + s) * NDH;
            if (kk == 0) gain = kn + NDH; else if (kk == 1) gain = kn + 2 * NDH; }
        if (gain) {
            float ss = 0.f; LANE_FOR(d, NDH) { const float x = bf2f(src[d]); ss += x * x; } ss = WAVE_SUM(ss);
            const float rinv = 1.0f / sqrtf(ss * (1.0f / NDH) + NORM_EPS);
            LANE_FOR(i, NDH / 2) { const float x1 = bf2f(src[i]) * rinv * gain[i], x2 = bf2f(src[i + NDH / 2]) * rinv * gain[i + NDH / 2];
                float cs, sn; rope_cs_((float)pos[r], 2 * i, NDH, cs, sn);
                dst[i] = f2bf(x1 * cs - x2 * sn); dst[i + NDH / 2] = f2bf(x2 * cs + x1 * sn); }
        } else if (k >= NH + 2 * NG && k < NH + 4 * NG) {
        } else { LANE_FOR(d, NDH) dst[d] = src[d]; }
        if (k == 0) { LANE_FOR(i, NH * 3) GT[r * NH * 3 + i] = sigmoidf_(bf2f(RAW[r * NSA_INP + D + 6 * KVW + i])); }
    }
}
constexpr int CBK = 32;
DEV void stage_cmp_bias_part(const Ctx& cx, const float* cpos, const float* w1, float* P) {
    constexpr int NCHK = CK / CBK; static_assert(CK % CBK == 0, "cmp bias chunks");
    ROW_FOR(tk, 2 * NCHK) { const int kv = (int)(tk / NCHK), ch = (int)(tk % NCHK);
        LANE_FOR(j, CHID) { float a = 0.f; for (int k = ch * CBK; k < (ch + 1) * CBK; ++k) a += cpos[(size_t)kv * CK + k] * w1[((size_t)kv * CK + k) * CHID + j];
            P[((size_t)ch * 2 + kv) * CHID + j] = a; } }
}
DEV void stage_cmp_bias_red(const Ctx& cx, const float* P, float* CMPBo) {
    constexpr int NCHK = CK / CBK;
    GRID_FOR(i, 2 * CHID) { float sacc = 0.f; for (int ch = 0; ch < NCHK; ++ch) sacc += P[(size_t)ch * 2 * CHID + i]; CMPBo[i] = sacc; }
}
DEV void stage_cmp2(const Ctx& cx, const bf16* HID, const float* w2, const float* kn, const int* pos, bf16* KC, bf16* VC) {
    ROW_FOR(q, (size_t)2 * NB * NG * NCV) {
        const int c = (int)(q % NCV); size_t q2 = q / NCV; const int bg = (int)(q2 % (NB * NG)); const int kv = (int)(q2 / (NB * NG)); const int b = bg / NG;
        const size_t m = (size_t)bg * NCB + c; const bf16* hp = HID + ((size_t)kv * CMP_M + m) * CHID; const float* wp = w2 + (size_t)kv * CHID * NDH;
        bf16* dst = KC + m * NDH; float ss = 0.f;
        LANE_FOR(d, NDH) { float v = 0.f; for (int j = 0; j < CHID; ++j) v += bf2f(hp[j]) * bf2f(f2bf(wp[j * NDH + d]));
            if (kv) VC[((size_t)bg * NDH + d) * NCB + c] = f2bf(v);
            else { dst[d] = f2bf(v); const float vr = bf2f(dst[d]); ss += vr * vr; } }
        if (kv == 0) {
            ss = WAVE_SUM(ss); const float rinv = 1.0f / sqrtf(ss * (1.0f / NDH) + NORM_EPS); const float pp = (float)pos[(size_t)b * S + c * CSTR];
            LANE_FOR(i, NDH / 2) { const float x1 = bf2f(dst[i]) * rinv * kn[i], x2 = bf2f(dst[i + NDH / 2]) * rinv * kn[i + NDH / 2];
                float cs, sn; rope_cs_(pp, 2 * i, NDH, cs, sn);
                dst[i] = f2bf(x1 * cs - x2 * sn); dst[i + NDH / 2] = f2bf(x2 * cs + x1 * sn); }
        }
    }
}
constexpr int AQT = 16, AQR = AQT * HG, AKT = 128;
DEV void stage_attn(const Ctx& cx, int mode, const bf16* QN, const bf16* Kc, const bf16* Vc, bf16* Out, unsigned* SELM) {
    constexpr int L_Q = 0, L_P = L_Q + AQR * NDH * 4, L_O = L_P + AQR * AKT * 4, L_M = L_O + AQR * NDH * 4, L_L = L_M + AQR * 4, L_A = L_L + AQR * 4, L_IMP = L_A + AQR * 4;
    const float scale = 1.0f / sqrtf((float)NDH);
    constexpr int NU = NB * NG * (S / AQT);
    for (int un = cx.bid; un < NU; un += cx.nblk) {
        const int tb = un % (S / AQT), g = (un / (S / AQT)) % NG, b = un / ((S / AQT) * NG); const int t0 = tb * AQT;
        const size_t kvrow = (mode == 0) ? NCB : S; const bf16* Kb = Kc + ((size_t)b * NG + g) * kvrow * NDH; const bf16* Vb = Vc + ((size_t)b * NG + g) * kvrow * NDH;
        int klo, khi;
        if (mode == 0) { klo = 0; khi = NCV; } else if (mode == 1) { klo = 0; khi = t0 + AQT; } else { klo = t0 - WIN + 1; if (klo < 0) klo = 0; klo = (klo / AKT) * AKT; khi = t0 + AQT; }
        FOR_THREADS(t) {
            for (int e = t; e < AQR * NDH; e += NT) { const int row = e / NDH, d = e % NDH, tl = row / HG, hh = row % HG;
                LDSP(float, L_Q)[e] = bf2f(QN[((size_t)b * S + t0 + tl) * D + (g * HG + hh) * NDH + d]) * scale; LDSP(float, L_O)[e] = 0.f; }
            if (t < AQR) { LDSP(float, L_M)[t] = -INFINITY; LDSP(float, L_L)[t] = 0.f; } }
        BLOCK_SYNC();
        for (int k0 = klo; k0 < khi; k0 += AKT) {
            FOR_THREADS(t) { for (int e = t; e < AQR * AKT; e += NT) { const int row = e / AKT, kk = e % AKT, s = k0 + kk, tt = t0 + row / HG; bool ok = s < khi;
                if (ok) { if (mode == 0) ok = (s * CSTR + CL - 1 <= tt); else if (mode == 1) ok = (s <= tt) && ((SELM[((size_t)b * NG + g) * S + tt] >> (s / SELB)) & 1u); else ok = (s <= tt) && (tt - s < WIN); }
                float sc = -INFINITY;
                if (ok) { sc = 0.f; const bf16* kp = Kb + (size_t)s * NDH; for (int d = 0; d < NDH; ++d) sc += LDSP(float, L_Q)[row * NDH + d] * bf2f(kp[d]); }
                LDSP(float, L_P)[e] = sc; } }
            BLOCK_SYNC();
            FOR_THREADS(t) { if (t < AQR) { float mx = -INFINITY; for (int kk = 0; kk < AKT; ++kk) mx = fmaxf(mx, LDSP(float, L_P)[t * AKT + kk]);
                const float mold = LDSP(float, L_M)[t], mnew = fmaxf(mold, mx); float al = 1.f, sum = 0.f;
                if (mnew == -INFINITY) { for (int kk = 0; kk < AKT; ++kk) LDSP(float, L_P)[t * AKT + kk] = 0.f; }
                else { al = (mold == -INFINITY) ? 0.f : expf(mold - mnew);
                    for (int kk = 0; kk < AKT; ++kk) { const float x = LDSP(float, L_P)[t * AKT + kk]; const float p = (x == -INFINITY) ? 0.f : expf(x - mnew); LDSP(float, L_P)[t * AKT + kk] = p; sum += p; } }
                LDSP(float, L_L)[t] = LDSP(float, L_L)[t] * al + sum; LDSP(float, L_M)[t] = mnew; LDSP(float, L_A)[t] = al; } }
            BLOCK_SYNC();
            FOR_THREADS(t) { for (int e = t; e < AQR * NDH; e += NT) { const int row = e / NDH, d = e % NDH; float a = LDSP(float, L_O)[e] * LDSP(float, L_A)[row];
                const int kmax = (khi - k0) < AKT ? (khi - k0) : AKT;
                for (int kk = 0; kk < kmax; ++kk) a += LDSP(float, L_P)[row * AKT + kk] * bf2f(Vb[(size_t)d * kvrow + (k0 + kk)]);
                LDSP(float, L_O)[e] = a; } }
            BLOCK_SYNC();
        }
        FOR_THREADS(t) { for (int e = t; e < AQR * NDH; e += NT) { const int row = e / NDH, d = e % NDH, tl = row / HG, hh = row % HG; const float l = LDSP(float, L_L)[row];
            Out[((size_t)b * S + t0 + tl) * D + (g * HG + hh) * NDH + d] = f2bf(l > 0.f ? LDSP(float, L_O)[e] / l : 0.f); } }
        if (mode == 0) {
            FOR_THREADS(t) { for (int e = t; e < AQT * NSEL; e += NT) { const int tl = e / NSEL, j = e % NSEL; float imp = 0.f;
                for (int hh = 0; hh < HG; ++hh) { const int row = tl * HG + hh; const float l = LDSP(float, L_L)[row]; if (l > 0.f) { float a = 0.f;
                    for (int c = 0; c < NCV; ++c) { const int cs = c * CSTR, js = j * SELB; const int lo = cs > js ? cs : js, hi = (cs + CL) < (js + SELB) ? (cs + CL) : (js + SELB);
                        if (hi > lo) a += LDSP(float, L_P)[row * AKT + c] * ((float)(hi - lo) / (float)CL); }
                    imp += a / l; } }
                LDSP(float, L_IMP)[e] = imp; } }
            BLOCK_SYNC();
            FOR_THREADS(t) { if (t < AQT) { const int tt = t0 + t, cur = tt / SELB; unsigned mask = 0u;
                if (cur + 1 <= TOPN) { for (int j = 0; j <= cur; ++j) mask |= 1u << j; }
                else { mask = 1u | (1u << cur) | (1u << (cur - 1));
                    for (int j = 1; j <= cur - 2; ++j) { const float v = LDSP(float, L_IMP)[t * NSEL + j]; int rank = 0;
                        for (int j2 = 1; j2 <= cur - 2; ++j2) { const float v2 = LDSP(float, L_IMP)[t * NSEL + j2]; if (v2 > v || (v2 == v && j2 < j)) ++rank; }
                        if (rank < TOPN - 3) mask |= 1u << j; } }
                SELM[((size_t)b * NG + g) * S + tt] = mask; } }
        }
        BLOCK_SYNC();
    }
}
DEV void stage_nsa_combine_host(const Ctx& cx, bf16* OWo, const bf16* OCi, const bf16* OSi, const float* GTi) {
    constexpr int NU = NB * NG * (S / AQT);
    for (int un = cx.bid; un < NU; un += cx.nblk) { const int tb = un % (S / AQT), g = (un / (S / AQT)) % NG, b = un / ((S / AQT) * NG);
        for (int tl = 0; tl < AQT; ++tl) for (int hh = 0; hh < HG; ++hh) { const size_t r = (size_t)b * S + tb * AQT + tl; const int h = g * HG + hh; const float* gp = GTi + (r * NH + h) * 3;
            for (int d = 0; d < NDH; ++d) { const size_t e = r * D + h * NDH + d; OWo[e] = f2bf(gp[0] * bf2f(OCi[e]) + gp[1] * bf2f(OSi[e]) + gp[2] * bf2f(OWo[e])); } } }
}
#ifndef HOST_SIM
__device__ __forceinline__ void nsa_prep1_gpu(const Ctx& cx, const bf16* RAW, const int* pos, const float* qn, const float* kn, bf16* QNo, bf16* KSo, bf16* KWo, bf16* KCRo, bf16* VCRo, float* GTo) {
    static_assert(NDH == 128 && NH == 8 && NG == 2, "nsa prep geometry");
    const int grp = cx.lane >> 4, l16 = cx.lane & 15;
    for (long r = (long)cx.bid * NWV + cx.wave; r < (long)T; r += (long)cx.nblk * NWV) {
        const int b = (int)(r / S), sx = (int)(r % S);
        U4 raws[4];
#pragma unroll
        for (int q = 0; q < 4; ++q) { const int k = q * 4 + grp; int colo;
            if (k < 8) colo = k * NDH; else { const int kk = (k - 8) >> 1, g = (k - 8) & 1; colo = (kk == 0 ? D + 2 * KVW : kk == 1 ? D + 4 * KVW : kk == 2 ? D : D + KVW) + g * NDH; }
            raws[q] = *(const U4*)(RAW + r * NSA_INP + colo + l16 * 8); }
        const float pp = (float)pos[r];
#pragma unroll
        for (int q = 0; q < 4; ++q) { const int k = q * 4 + grp;
        bf16* dst; const float* gain = nullptr;
        if (k < 8) { dst = QNo + r * D + k * NDH; gain = qn; }
        else { const int kk = (k - 8) >> 1, g = (k - 8) & 1;
            dst = (kk == 0 ? KSo : kk == 1 ? KWo : kk == 2 ? KCRo : VCRo) + (((size_t)b * NG + g) * S + sx) * NDH;
            if (kk == 0) gain = kn + NDH; else if (kk == 1) gain = kn + 2 * NDH; }
        const U4 raw = raws[q];
        if (gain) {
            const unsigned w[4] = {raw.x, raw.y, raw.z, raw.w}; float x[8], ss = 0.f;
#pragma unroll
            for (int e = 0; e < 8; ++e) { x[e] = bf2f((bf16)((e & 1) ? (w[e >> 1] >> 16) : (w[e >> 1] & 0xffffu))); ss += x[e] * x[e]; }
            ss += __shfl_xor(ss, 1); ss += __shfl_xor(ss, 2); ss += __shfl_xor(ss, 4); ss += __shfl_xor(ss, 8);
            const float rinv = 1.0f / sqrtf(ss * (1.0f / NDH) + NORM_EPS);
            float y[8], yp[8];
#pragma unroll
            for (int e = 0; e < 8; ++e) y[e] = x[e] * rinv * gain[l16 * 8 + e];
#pragma unroll
            for (int e = 0; e < 8; ++e) yp[e] = __shfl_xor(y[e], 8);
            float o[8];
#pragma unroll
            for (int e = 0; e < 8; ++e) { float cs, sn; rope_cs_(pp, 2 * ((l16 & 7) * 8 + e), NDH, cs, sn); o[e] = (l16 < 8) ? (y[e] * cs - yp[e] * sn) : (y[e] * cs + yp[e] * sn); }
            U4 ow; ow.x = pk2(o[0], o[1]); ow.y = pk2(o[2], o[3]); ow.z = pk2(o[4], o[5]); ow.w = pk2(o[6], o[7]);
            *(U4*)(dst + l16 * 8) = ow;
        } else { *(U4*)(dst + l16 * 8) = raw; }
        }
    }
    GRID_FOR(i, (size_t)T * NH * 3) { const size_t r = i / (NH * 3); const int j = (int)(i % (NH * 3)); GTo[i] = sigmoidf_(bf2f(RAW[r * NSA_INP + D + 6 * KVW + j])); }
}
#define NSAPREP1(raw, pos, qn, kn, q, ks, vs, kw, vw, kcr, vcr, gt) nsa_prep1_gpu(cx, raw, pos, qn, kn, q, ks, kw, kcr, vcr, gt)
#else
#define NSAPREP1(raw, pos, qn, kn, q, ks, vs, kw, vw, kcr, vcr, gt) stage_nsa_prep1(cx, raw, pos, qn, kn, q, ks, vs, kw, vw, kcr, vcr, gt)
#endif
#ifndef HOST_SIM
DEV void prep_w2t(const Ctx& cx, const float* w2, bf16* W2T) {
    GRID_FOR(e, (size_t)2 * NDH * CHID) { const int k = (int)(e % CHID), n = (int)((e / CHID) % NDH), kv = (int)(e / ((size_t)CHID * NDH)); W2T[e] = f2bf(w2[((size_t)kv * CHID + k) * NDH + n]); }
}
__device__ __forceinline__ void cmp2_gpu(const Ctx& cx, const bf16* HID, const bf16* W2T, const float* kn, const int* pos, bf16* KC, bf16* VC) {
    static_assert(NDH == 128 && CHID % 32 == 0 && CMP_M % 16 == 0, "cmp2 geometry");
    typedef short bf16x8_ __attribute__((ext_vector_type(8))); typedef float f32x4_ __attribute__((ext_vector_type(4)));
    const int l16 = cx.lane & 15, lg = cx.lane >> 4; constexpr int NTL = 2 * (CMP_M / 16);
    for (int it = cx.bid + cx.nblk * cx.wave; it < NTL; it += cx.nblk * NWV) {
        const int kv = it / (CMP_M / 16), m = (it % (CMP_M / 16)) * 16 + l16; const int c = m % NCB, bg = m / NCB;
        const bf16* hp = HID + ((size_t)kv * CMP_M + m) * CHID + lg * 8; const bf16* wp = W2T + ((size_t)kv * NDH + l16) * CHID + lg * 8;
        f32x4_ acc[8];
#pragma unroll
        for (int nb = 0; nb < 8; ++nb) acc[nb] = (f32x4_){0.f, 0.f, 0.f, 0.f};
#pragma unroll 2
        for (int kb = 0; kb < CHID / 32; ++kb) { const bf16x8_ hb = *(const bf16x8_*)(hp + kb * 32);
#pragma unroll
            for (int nb = 0; nb < 8; ++nb) { const bf16x8_ wa = *(const bf16x8_*)(wp + (size_t)nb * 16 * CHID + kb * 32); acc[nb] = __builtin_amdgcn_mfma_f32_16x16x32_bf16(wa, hb, acc[nb], 0, 0, 0); } }
        if (c < NCV) {
            if (kv) {
#pragma unroll
                for (int nb = 0; nb < 8; ++nb)
#pragma unroll
                    for (int i = 0; i < 4; ++i) VC[((size_t)bg * NDH + nb * 16 + lg * 4 + i) * NCB + c] = f2bf(acc[nb][i]);
            }
        }
        if (!kv) {
            float ss = 0.f;
#pragma unroll
            for (int nb = 0; nb < 8; ++nb)
#pragma unroll
                for (int i = 0; i < 4; ++i) { const float vr = bf2f(f2bf(acc[nb][i])); acc[nb][i] = vr; ss += vr * vr; }
            ss += __shfl_xor(ss, 16); ss += __shfl_xor(ss, 32);
            const float rinv = 1.0f / sqrtf(ss * (1.0f / NDH) + NORM_EPS); const float pp = (float)pos[(size_t)(bg / NG) * S + (c < NCV ? c : 0) * CSTR];
            bf16* dst = KC + (size_t)m * NDH + lg * 4;
#pragma unroll
            for (int nb = 0; nb < 4; ++nb) { float o1[4], o2[4];
#pragma unroll
                for (int i = 0; i < 4; ++i) { const int d = nb * 16 + lg * 4 + i; const float x1 = acc[nb][i] * rinv * kn[d], x2 = acc[nb + 4][i] * rinv * kn[d + NDH / 2];
                    float cs, sn; rope_cs_(pp, 2 * d, NDH, cs, sn); o1[i] = x1 * cs - x2 * sn; o2[i] = x2 * cs + x1 * sn; }
                if (c < NCV) { U2 a, b2; a.x = pk2(o1[0], o1[1]); a.y = pk2(o1[2], o1[3]); b2.x = pk2(o2[0], o2[1]); b2.y = pk2(o2[2], o2[3]);
                    *(U2*)(dst + nb * 16) = a; *(U2*)(dst + nb * 16 + NDH / 2) = b2; } }
        }
    }
}
#define CMP2(hid, w2f, w2t, kn, pos, kc, vc) cmp2_gpu(cx, hid, w2t, kn, pos, kc, vc)
#define PREP_W2T(w2, w2t) prep_w2t(cx, w2, w2t)
#else
#define PREP_W2T(w2, w2t) do {} while (0)
#define CMP2(hid, w2f, w2t, kn, pos, kc, vc) stage_cmp2(cx, hid, w2f, kn, pos, kc, vc)
#endif
#ifndef HOST_SIM
namespace att {
typedef short bf16x8 __attribute__((ext_vector_type(8)));
typedef float f32x16 __attribute__((ext_vector_type(16)));
typedef unsigned u32x4 __attribute__((ext_vector_type(4)));
constexpr int L_K = 0, L_V = 16384, L_B2 = 32768, L_W = 65536, WSCR = 1280;
__device__ __forceinline__ int kswz(int row, int colB) { return row * 256 + (colB ^ ((row & 7) << 4)); }
__device__ __forceinline__ int vswz(int row, int colB) { return row * 128 + (colB ^ ((row & 7) << 4)); }
__device__ __forceinline__ int crow(int r, int hi) { return (r & 3) + 8 * (r >> 2) + 4 * hi; }
__device__ __forceinline__ unsigned cvtpk(float lo, float hi) { unsigned r; asm volatile("v_cvt_pk_bf16_f32 %0, %1, %2" : "=v"(r) : "v"(lo), "v"(hi)); return r; }
__device__ __forceinline__ float swapmax(float v) { auto rr = __builtin_amdgcn_permlane32_swap(__float_as_uint(v), __float_as_uint(v), false, false); return fmaxf(__uint_as_float(rr[0]), __uint_as_float(rr[1])); }
__device__ __forceinline__ float swapsum(float v) { auto rr = __builtin_amdgcn_permlane32_swap(__float_as_uint(v), __float_as_uint(v), false, false); return __uint_as_float(rr[0]) + __uint_as_float(rr[1]); }
#define ATT_PK4(P, B_, OUT) do { unsigned a0 = cvtpk(P[B_ + 0], P[B_ + 1]), a1 = cvtpk(P[B_ + 2], P[B_ + 3]); unsigned b0 = cvtpk(P[B_ + 4], P[B_ + 5]), b1 = cvtpk(P[B_ + 6], P[B_ + 7]); \
        auto r0 = __builtin_amdgcn_permlane32_swap(a0, b0, false, false); auto r1 = __builtin_amdgcn_permlane32_swap(a1, b1, false, false); \
        u32x4 w = {r0[0], r1[0], r0[1], r1[1]}; OUT = *reinterpret_cast<bf16x8*>(&w); } while (0)
template <int MODE>
__device__ __forceinline__ void attn_mfma(const Ctx& cx, const bf16* QNp, const bf16* Kc, const bf16* Vt, bf16* Out, unsigned* SELMp, const bf16* OCp = nullptr, const bf16* OSp = nullptr, const float* GTp = nullptr) {
    static_assert(NDH == 128 && HG == 4 && SELB == 64 && NB * NG * 8 == 256 && S == 2048, "attention body geometry");
    const int tid = cx.tid, wid = cx.wave, lane = cx.lane, r32 = lane & 31, hi = lane >> 5;
    LAS unsigned char* lds = cx.lds;
    LAS float* wsc = (LAS float*)(lds + L_W + wid * WSCR); LAS float* al_l = wsc; LAS float* li_l = wsc + 32; LAS float* impw = wsc + 64;
    constexpr int KROWS = MODE == 0 ? NCB : S, NTB = S / 64, NUNITS = NB * NG * NTB;
    constexpr float C2 = 1.4426950408889634f * 0.08838834764831845f;
    const float NEG = -__builtin_inff();
    for (int it = 0;; ++it) {
        const int u = it * cx.nblk + cx.bid; if (u >= NUNITS) break;
        int bg, tb;
        if (cx.nblk == 256) { const int xcd = cx.bid & 7, li = cx.bid >> 3; bg = xcd * 4 + (li >> 3); const int x = li & 7;
            tb = it == 0 ? x : it == 1 ? 15 - x : it == 2 ? 16 + x : 31 - x; }
        else { bg = u / NTB; tb = u % NTB; }
        const int b = bg / NG, g = bg % NG, t0 = tb * 64;
        const int row = wid * 32 + r32, pos = t0 + (row >> 2);
        const bf16* qp = QNp + ((size_t)b * S + pos) * D + (g * HG + (row & 3)) * NDH;
        bf16x8 qr[8];
#pragma unroll
        for (int d0 = 0; d0 < 8; ++d0) qr[d0] = *(const bf16x8*)(qp + d0 * 16 + hi * 8);
        int klo = 0, khi = pos, j_lo = 0, j_hi = tb + 1; unsigned tmask = 0xffffffffu;
        if (MODE == 0) { khi = pos >= CL - 1 ? (pos - (CL - 1)) / CSTR : -1; if (khi > NCV - 1) khi = NCV - 1; j_hi = (NCV + 63) / 64; }
        else if (MODE == 1) { tmask = SELMp[(size_t)bg * S + pos]; }
        else { klo = pos - WIN + 1; const int lk = t0 - WIN + 1; j_lo = lk > 0 ? lk / 64 : 0; }
        float m_reg = -1e30f, l_reg = 0.f; f32x16 o[4] = {}; f32x16 oi = {};
        const bf16* Kb = Kc + (size_t)bg * KROWS * NDH; const bf16* Vb = Vt + (size_t)bg * NDH * KROWS;
        u32x4 pk[2], pv[2];
#define ATT_LOAD(j_) do { _Pragma("unroll") for (int i = 0; i < 2; ++i) { const int p = tid + 512 * i; pk[i] = *(const u32x4*)(Kb + (size_t)((j_) * 64 + (p >> 4)) * NDH + (p & 15) * 8); \
            pv[i] = *(const u32x4*)(Vb + (size_t)(p >> 3) * KROWS + (j_) * 64 + (p & 7) * 8); } } while (0)
#define ATT_PUT(boff_) do { _Pragma("unroll") for (int i = 0; i < 2; ++i) { const int p = tid + 512 * i; \
            *(LAS u32x4*)(lds + (boff_) + L_K + kswz(p >> 4, (p & 15) * 16)) = pk[i]; *(LAS u32x4*)(lds + (boff_) + L_V + vswz(p >> 3, (p & 7) * 16)) = pv[i]; } } while (0)
        if (MODE != 0) { __syncthreads();
            ATT_LOAD(j_lo); ATT_PUT(0); if (j_lo + 1 < j_hi) ATT_LOAD(j_lo + 1); }
        for (int j = j_lo; j < j_hi; ++j) {
            int boff = 0;
            if (MODE == 0) {
                __syncthreads();
                ATT_LOAD(j); ATT_PUT(0);
                __syncthreads();
            } else {
                __syncthreads();
                boff = ((j - j_lo) & 1) * L_B2;
                if (j + 1 < j_hi) { ATT_PUT(L_B2 - boff); if (j + 2 < j_hi) ATT_LOAD(j + 2); }
            }
            f32x16 p0 = {}, p1 = {};
#pragma unroll
            for (int d0 = 0; d0 < 8; ++d0) { const int ko = kswz(r32, (d0 * 16 + hi * 8) * 2);
                const bf16x8 k0 = *(const LAS bf16x8*)(lds + boff + L_K + ko), k1 = *(const LAS bf16x8*)(lds + boff + L_K + ko + 32 * 256);
                p0 = __builtin_amdgcn_mfma_f32_32x32x16_bf16(k0, qr[d0], p0, 0, 0, 0); p1 = __builtin_amdgcn_mfma_f32_32x32x16_bf16(k1, qr[d0], p1, 0, 0, 0); }
            { const bool tok = (tmask >> j) & 1u; const int kb = j * 64 + 4 * hi;
              const bool inner = tok && (j * 64 >= klo) && (j * 64 + 63 <= khi);
              if (!__all(inner)) {
#pragma unroll
              for (int r = 0; r < 16; ++r) { const int k0 = kb + (r & 3) + 8 * (r >> 2), k1 = k0 + 32;
                  if (!(tok && k0 >= klo && k0 <= khi)) p0[r] = NEG; if (!(tok && k1 >= klo && k1 <= khi)) p1[r] = NEG; } } }
            float pmax = p0[0];
#pragma unroll
            for (int r = 1; r < 16; ++r) pmax = fmaxf(pmax, p0[r]);
#pragma unroll
            for (int r = 0; r < 16; ++r) pmax = fmaxf(pmax, p1[r]);
            pmax = swapmax(pmax);
            const float mn = fmaxf(m_reg, pmax), alpha = __builtin_amdgcn_exp2f((m_reg - mn) * C2), mnL = -mn * C2; m_reg = mn;
            float ps = 0.f;
#pragma unroll
            for (int r = 0; r < 16; ++r) { p0[r] = __builtin_amdgcn_exp2f(fmaf(p0[r], C2, mnL)); p1[r] = __builtin_amdgcn_exp2f(fmaf(p1[r], C2, mnL)); ps += p0[r] + p1[r]; }
            ps = swapsum(ps); l_reg = l_reg * alpha + ps;
            bf16x8 pa0, pa1, pa2, pa3;
            ATT_PK4(p0, 0, pa0); ATT_PK4(p0, 8, pa1); ATT_PK4(p1, 0, pa2); ATT_PK4(p1, 8, pa3);
            if (__any(alpha < 1.f)) { if (hi == 0) al_l[r32] = alpha; asm volatile("s_waitcnt lgkmcnt(0)" ::: "memory");
#pragma unroll
                for (int r = 0; r < 16; ++r) { const float a = al_l[crow(r, hi)];
#pragma unroll
                    for (int d = 0; d < 4; ++d) o[d][r] *= a;
                    if (MODE == 0) oi[r] *= a; } }
#pragma unroll
            for (int d0 = 0; d0 < 4; ++d0) { const int rd = d0 * 32 + r32;
                const bf16x8 v0 = *(const LAS bf16x8*)(lds + boff + L_V + vswz(rd, (0 + 8 * hi) * 2)), v1 = *(const LAS bf16x8*)(lds + boff + L_V + vswz(rd, (16 + 8 * hi) * 2)),
                             v2 = *(const LAS bf16x8*)(lds + boff + L_V + vswz(rd, (32 + 8 * hi) * 2)), v3 = *(const LAS bf16x8*)(lds + boff + L_V + vswz(rd, (48 + 8 * hi) * 2));
                o[d0] = __builtin_amdgcn_mfma_f32_32x32x16_bf16(pa0, v0, o[d0], 0, 0, 0); o[d0] = __builtin_amdgcn_mfma_f32_32x32x16_bf16(pa1, v1, o[d0], 0, 0, 0);
                o[d0] = __builtin_amdgcn_mfma_f32_32x32x16_bf16(pa2, v2, o[d0], 0, 0, 0); o[d0] = __builtin_amdgcn_mfma_f32_32x32x16_bf16(pa3, v3, o[d0], 0, 0, 0); }
            if (MODE == 0) {
#pragma unroll
                for (int kk = 0; kk < 4; ++kk) { float mv[8];
#pragma unroll
                    for (int i = 0; i < 8; ++i) { const int c = j * 64 + kk * 16 + 8 * hi + i, cs = c * CSTR, js = r32 * SELB; const int lo = cs > js ? cs : js, hiE = (cs + CL) < (js + SELB) ? (cs + CL) : (js + SELB);
                        mv[i] = hiE > lo ? (float)(hiE - lo) * (1.0f / CL) : 0.f; }
                    u32x4 w = {cvtpk(mv[0], mv[1]), cvtpk(mv[2], mv[3]), cvtpk(mv[4], mv[5]), cvtpk(mv[6], mv[7])}; const bf16x8 mf = *reinterpret_cast<bf16x8*>(&w);
                    oi = __builtin_amdgcn_mfma_f32_32x32x16_bf16(kk == 0 ? pa0 : kk == 1 ? pa1 : kk == 2 ? pa2 : pa3, mf, oi, 0, 0, 0); } }
        }
        if (hi == 0) li_l[r32] = l_reg; asm volatile("s_waitcnt lgkmcnt(0)" ::: "memory");
        float rli[16];
#pragma unroll
        for (int r = 0; r < 16; ++r) { const float l = li_l[crow(r, hi)]; rli[r] = l > 0.f ? __builtin_amdgcn_rcpf(l) : 0.f; }
        if (MODE == 2 && GTp) {
#pragma unroll
            for (int rh = 0; rh < 16; rh += 8) {
                float gg0[8], gg1[8], gg2[8];
#pragma unroll
                for (int k = 0; k < 8; ++k) { const int r = rh + k, R = wid * 32 + crow(r, hi); const size_t tokr = (size_t)b * S + t0 + (R >> 2); const float* gp = GTp + (tokr * NH + g * HG + (R & 3)) * 3;
                    gg0[k] = gp[0]; gg1[k] = gp[1]; gg2[k] = gp[2] * rli[r]; }
#pragma unroll
                for (int d0 = 0; d0 < 4; ++d0) { bf16 coc[8], cos_[8];
#pragma unroll
                    for (int k = 0; k < 8; ++k) { const int r = rh + k, R = wid * 32 + crow(r, hi); const size_t eo = ((size_t)b * S + t0 + (R >> 2)) * D + (g * HG + (R & 3)) * NDH + d0 * 32 + r32; coc[k] = OCp[eo]; cos_[k] = OSp[eo]; }
#pragma unroll
                    for (int k = 0; k < 8; ++k) { const int r = rh + k, R = wid * 32 + crow(r, hi); const size_t eo = ((size_t)b * S + t0 + (R >> 2)) * D + (g * HG + (R & 3)) * NDH + d0 * 32 + r32;
                        const float v = gg2[k] * o[d0][r] + gg0[k] * bf2f(coc[k]) + gg1[k] * bf2f(cos_[k]); const float vn = __shfl_xor(v, 1);
                        if ((r32 & 1) == 0) *(unsigned*)(Out + eo) = cvtpk(v, vn); } } }
        } else {
#pragma unroll
        for (int r = 0; r < 16; ++r) { const int R = wid * 32 + crow(r, hi); const size_t tokr = (size_t)b * S + t0 + (R >> 2); const size_t eo = tokr * D + (g * HG + (R & 3)) * NDH; bf16* op = Out + eo;
#pragma unroll
            for (int d0 = 0; d0 < 4; ++d0) { const float v = o[d0][r] * rli[r]; const float vn = __shfl_xor(v, 1);
                if ((r32 & 1) == 0) *(unsigned*)(op + d0 * 32 + r32) = cvtpk(v, vn); } }
        }
        if (MODE == 0) {
#pragma unroll
            for (int q = 0; q < 4; ++q) { const float sm = oi[4 * q] * rli[4 * q] + oi[4 * q + 1] * rli[4 * q + 1] + oi[4 * q + 2] * rli[4 * q + 2] + oi[4 * q + 3] * rli[4 * q + 3];
                impw[(2 * q + hi) * 32 + r32] = sm; }
            asm volatile("s_waitcnt lgkmcnt(0)" ::: "memory");
#pragma unroll
            for (int i = 0; i < 4; ++i) { const int tk = 2 * i + hi, jb = r32; bool sel = false;
                if (tb + 1 <= TOPN) sel = jb <= tb;
                else if (jb == 0 || jb == tb || jb == tb - 1) sel = true;
                else if (jb < tb - 1) { const float v = impw[tk * 32 + jb]; int rank = 0;
                    for (int j2 = 1; j2 <= tb - 2; ++j2) { const float v2 = impw[tk * 32 + j2]; rank += (v2 > v || (v2 == v && j2 < jb)) ? 1 : 0; }
                    sel = rank < TOPN - 3; }
                const unsigned long long bal = __ballot(sel);
                if (lane == 0) { SELMp[(size_t)bg * S + t0 + wid * 8 + 2 * i] = (unsigned)bal; SELMp[(size_t)bg * S + t0 + wid * 8 + 2 * i + 1] = (unsigned)(bal >> 32); } }
        }
    }
    __syncthreads();
}
#undef ATT_PK4
#undef ATT_LOAD
#undef ATT_PUT
}
namespace s5 {
typedef short bf16x4 __attribute__((ext_vector_type(4)));
typedef short bf16x8 __attribute__((ext_vector_type(8)));
typedef float f32x4 __attribute__((ext_vector_type(4)));
typedef unsigned u32x2 __attribute__((ext_vector_type(2)));
typedef unsigned u32x4 __attribute__((ext_vector_type(4)));
__device__ __forceinline__ void core_mfma(const Ctx& cx, const bf16* U, bf16* Y, const float* AB, const float* BB, const float* c_re, const float* c_im, const float* dskip) {
    static_assert(SP == 64 && SGC == 16 && NT == 512 && S == 2048, "s5 body geometry");
    constexpr int NSEG = 8, SEGL = S / NSEG, MC = 16, RS = 132, TILEB = MC * RS * 4, L_XEND = NSEG * TILEB, L_XIN = L_XEND + NSEG * SP * 8;
    const int w = cx.wave, lane = cx.lane, fr = lane & 15, fq = lane >> 4;
    LAS float* tile = (LAS float*)(cx.lds + w * TILEB);
    LAS float* xend = (LAS float*)(cx.lds + L_XEND); LAS float* xin = (LAS float*)(cx.lds + L_XIN);
    constexpr int UPW = 4;
    for (int un0 = cx.bid * UPW; un0 < NB * SG; un0 += cx.nblk * UPW)
    for (int un = un0; un < un0 + UPW && un < NB * SG; ++un) {
        const int g = un % SG, b = un / SG;
        const float abr = AB[(g * SP + lane) * 4], abi = AB[(g * SP + lane) * 4 + 1];
        bf16x4 bB[8];
#pragma unroll
        for (int j = 0; j < 8; ++j) { const int n = 16 * j + fr, p_ = n & 63, ri = n >> 6; const float* bp = BB + ((size_t)(g * SP + p_) * SGC + 4 * fq) * 2 + ri;
            const u32x2 v = {pk2(bp[0], bp[2]), pk2(bp[4], bp[6])}; bB[j] = *reinterpret_cast<const bf16x4*>(&v); }
        bf16x8 cB[4];
#pragma unroll
        for (int kk = 0; kk < 4; ++kk) { const int k0 = 32 * kk + 8 * fq; const float* cp = (k0 < 64 ? c_re : c_im) + ((size_t)g * SGC + fr) * SP + (k0 & 63); const float sg = k0 < 64 ? 1.f : -1.f;
            const u32x4 v = {pk2(sg * cp[0], sg * cp[1]), pk2(sg * cp[2], sg * cp[3]), pk2(sg * cp[4], sg * cp[5]), pk2(sg * cp[6], sg * cp[7])}; cB[kk] = *reinterpret_cast<const bf16x8*>(&v); }
        bf16x4 dB;
        { const float dv = dskip[g * SGC + fr]; const u32x2 v = {pk2(4 * fq + 0 == fr ? dv : 0.f, 4 * fq + 1 == fr ? dv : 0.f), pk2(4 * fq + 2 == fr ? dv : 0.f, 4 * fq + 3 == fr ? dv : 0.f)}; dB = *reinterpret_cast<const bf16x4*>(&v); }
        const bf16* ub = U + ((size_t)b * S + (size_t)w * SEGL + fr) * D + g * SGC + 4 * fq;
        float xr = 0.f, xi = 0.f;
#pragma nounroll
        for (int pass = 0; pass < 2; ++pass) {
            if (pass == 1) { xr = xin[(w * SP + lane) * 2]; xi = xin[(w * SP + lane) * 2 + 1]; }
            u32x2 unext = *(const u32x2*)ub;
#pragma nounroll
            for (int ch = 0; ch < SEGL / MC; ++ch) {
                const u32x2 uraw = unext; const bf16x4 aU = *reinterpret_cast<const bf16x4*>(&uraw);
                if (ch + 1 < SEGL / MC) unext = *(const u32x2*)(ub + (size_t)(ch + 1) * MC * D);
#pragma unroll
                for (int j = 0; j < 8; ++j) { const f32x4 acc = __builtin_amdgcn_mfma_f32_16x16x16bf16_1k(aU, bB[j], (f32x4){0.f, 0.f, 0.f, 0.f}, 0, 0, 0);
#pragma unroll
                    for (int i = 0; i < 4; ++i) tile[(4 * fq + i) * RS + 16 * j + fr] = acc[i]; }
                asm volatile("s_waitcnt lgkmcnt(0)" ::: "memory");
#pragma unroll
                for (int t = 0; t < MC; ++t) { const float br = tile[t * RS + lane], bi = tile[t * RS + 64 + lane];
                    const float nr = abr * xr - abi * xi + br, ni = abr * xi + abi * xr + bi; xr = nr; xi = ni;
                    if (pass == 1) { tile[t * RS + lane] = xr; tile[t * RS + 64 + lane] = xi; } }
                if (pass == 1) {
                    asm volatile("s_waitcnt lgkmcnt(0)" ::: "memory");
                    f32x4 ya = __builtin_amdgcn_mfma_f32_16x16x16bf16_1k(aU, dB, (f32x4){0.f, 0.f, 0.f, 0.f}, 0, 0, 0);
#pragma unroll
                    for (int kk = 0; kk < 4; ++kk) { const f32x4 x0 = *(const LAS f32x4*)(tile + fr * RS + 32 * kk + 8 * fq), x1 = *(const LAS f32x4*)(tile + fr * RS + 32 * kk + 8 * fq + 4);
                        const u32x4 v = {pk2(x0[0], x0[1]), pk2(x0[2], x0[3]), pk2(x1[0], x1[1]), pk2(x1[2], x1[3])};
                        ya = __builtin_amdgcn_mfma_f32_16x16x32_bf16(*reinterpret_cast<const bf16x8*>(&v), cB[kk], ya, 0, 0, 0); }
                    bf16* yp = Y + ((size_t)b * S + (size_t)w * SEGL + ch * MC + 4 * fq) * D + g * SGC + fr;
#pragma unroll
                    for (int i = 0; i < 4; ++i) yp[(size_t)i * D] = f2bf(geluf_(ya[i]));
                    asm volatile("s_waitcnt lgkmcnt(0)" ::: "memory");
                }
            }
            if (pass == 0) {
                xend[(w * SP + lane) * 2] = xr; xend[(w * SP + lane) * 2 + 1] = xi;
                __syncthreads();
                if (w == 0) { const float pr = AB[(g * SP + lane) * 4 + 2], pi = AB[(g * SP + lane) * 4 + 3]; float cr = 0.f, ci = 0.f;
                    for (int q = 0; q < NSEG; ++q) { xin[(q * SP + lane) * 2] = cr; xin[(q * SP + lane) * 2 + 1] = ci; const float er = xend[(q * SP + lane) * 2], ei = xend[(q * SP + lane) * 2 + 1];
                        const float nr = pr * cr - pi * ci + er, ni = pr * ci + pi * cr + ei; cr = nr; ci = ni; } }
                __syncthreads();
            }
        }
        __syncthreads();
    }
}
}
#define S5CORE(u, y, ab, bb, cre, cim, dsk) s5::core_mfma(cx, u, y, ab, bb, cre, cim, dsk)
namespace ret {
using att::bf16x8; using att::f32x16; using att::u32x4; using att::cvtpk; using att::crow;
__device__ __forceinline__ int rtswz(int v, int chunk) { return v * 512 + ((chunk ^ (v & 15)) << 4); }
#define RET_PK4(P, B_, OUT) do { unsigned a0 = cvtpk(P[B_ + 0], P[B_ + 1]), a1 = cvtpk(P[B_ + 2], P[B_ + 3]); unsigned b0 = cvtpk(P[B_ + 4], P[B_ + 5]), b1 = cvtpk(P[B_ + 6], P[B_ + 7]); \
        auto r0 = __builtin_amdgcn_permlane32_swap(a0, b0, false, false); auto r1 = __builtin_amdgcn_permlane32_swap(a1, b1, false, false); \
        u32x4 w = {r0[0], r1[0], r0[1], r1[1]}; OUT = *reinterpret_cast<bf16x8*>(&w); } while (0)
__device__ __forceinline__ void core_mfma(const Ctx& cx, const bf16* RAW, const bf16* KT, const bf16* VT, bf16* O) {
    static_assert(RDK == 256 && RDV == 512 && RC == 64 && RH == 4 && S % RC == 0, "retention body geometry");
    const int tid = cx.tid, wid = cx.wave, lane = cx.lane, r32 = lane & 31, hi = lane >> 5;
    LAS unsigned char* lds = cx.lds;
    constexpr int NU = NB * RH * 4, NCH = S / RC, L_Q = 65536, L_K = 98304, L_V = 131072;
    const unsigned qk_voff = (unsigned)(((tid >> 5) * RIN + (tid & 31) * 8) * 2);
    const int qk_lds = (tid >> 5) * 512 + (((tid & 31) ^ ((tid >> 5) & 15)) << 4);
    const int vj = tid & 63, vc = tid >> 6;
    for (int un0 = cx.bid; un0 < NU; un0 += cx.nblk) {
        int un = un0; if (cx.nblk == 256) un = ((un0 & 7) * 8 + (un0 >> 5)) * 4 + ((un0 >> 3) & 3);
        const int vs = un & 3, h = (un >> 2) & 3, b = un >> 4;
        const float lg2 = log2_gamma_(h), cd = __builtin_amdgcn_exp2f((float)RC * lg2), rcd = 1.0f / cd;
        const int ib = wid >> 2, vb = wid & 3;
        f32x16 Racc[4] = {};
        const char* qbase = (const char*)(RAW + (size_t)b * S * RIN + h * RDK); const char* kbase = (const char*)(RAW + (size_t)b * S * RIN + RH * RDK + h * RDK);
        const char* vbase = (const char*)(RAW + (size_t)b * S * RIN + 2 * RH * RDK + h * RDV + vs * 128);
        const bf16* ktrow = KT + ((size_t)b * RH * RDK + h * RDK + 32 * wid + r32) * S;
        u32x4 pq[4], pk[4], pv[2];
#define RET_LOAD(n_) do { _Pragma("unroll") for (int i_ = 0; i_ < 4; ++i_) { const size_t ro_ = ((size_t)(n_) * RC + 16 * i_) * RIN * 2; pq[i_] = *(const u32x4*)(qbase + ro_ + qk_voff); pk[i_] = *(const u32x4*)(kbase + ro_ + qk_voff); } \
        _Pragma("unroll") for (int i_ = 0; i_ < 2; ++i_) pv[i_] = *(const u32x4*)(vbase + ((size_t)(n_) * RC + vj) * RIN * 2 + (vc + 8 * i_) * 16); } while (0)
#define RET_PUT_QK() do { _Pragma("unroll") for (int i_ = 0; i_ < 4; ++i_) { *(LAS u32x4*)(lds + L_Q + qk_lds + i_ * 8192) = pq[i_]; *(LAS u32x4*)(lds + L_K + qk_lds + i_ * 8192) = pk[i_]; } } while (0)
#define RET_PUT_V() do { int vj_ = vj; asm volatile("" : "+v"(vj_));   _Pragma("unroll") for (int i_ = 0; i_ < 2; ++i_) { _Pragma("unroll") for (int e_ = 0; e_ < 8; ++e_) { const int v_ = (vc + 8 * i_) * 8 + e_; \
            const unsigned w_ = pv[i_][e_ >> 1]; *(LAS unsigned short*)(lds + L_V + v_ * 128 + ((((vj_ >> 3) ^ (v_ & 7))) << 4) + (vj_ & 7) * 2) = (unsigned short)((e_ & 1) ? (w_ >> 16) : (w_ & 0xffffu)); } } } while (0)
        { unsigned z0 = 0u; asm volatile("" : "+v"(z0));
          for (int idx = tid; idx < 65536 / 16; idx += NT) *(LAS u32x4*)(lds + idx * 16) = (u32x4){z0, z0, z0, z0}; }
        RET_LOAD(0); RET_PUT_QK(); RET_PUT_V();
        __syncthreads();
        const int qrow = L_Q + (32 * ib + r32) * 512, rx = r32 & 15, vrow = L_V + (32 * vb + r32) * 128, vx = r32 & 7;
#pragma nounroll
        for (int n = 0; n < NCH; ++n) {
            const size_t r0 = (size_t)b * S + (size_t)n * RC;
            f32x16 o = {};
#pragma unroll
            for (int kk = 0; kk < 16; ++kk) { const int ch = 2 * kk + hi;
                const bf16x8 qf = *(const LAS bf16x8*)(lds + qrow + ((ch ^ rx) << 4)), rb = *(const LAS bf16x8*)(lds + rtswz(32 * vb + r32, ch));
                o = __builtin_amdgcn_mfma_f32_32x32x16_bf16(qf, rb, o, 0, 0, 0);
                if ((kk & 3) == 3) { asm volatile("" ::: "memory"); } }
#pragma nounroll
            for (int jb = 0; jb <= ib; ++jb) {
                f32x16 p = {};
                const int krow = L_K + (32 * jb + r32) * 512;
#pragma unroll
                for (int kk = 0; kk < 16; ++kk) { const int ch = 2 * kk + hi;
                    const bf16x8 kf = *(const LAS bf16x8*)(lds + krow + ((ch ^ rx) << 4)), qf = *(const LAS bf16x8*)(lds + qrow + ((ch ^ rx) << 4));
                    p = __builtin_amdgcn_mfma_f32_32x32x16_bf16(kf, qf, p, 0, 0, 0);
                    if ((kk & 3) == 3) { asm volatile("" ::: "memory"); } }
                { const int lim = (jb == ib ? r32 : 1024) - 4 * hi;
#pragma unroll
                  for (int r = 0; r < 16; ++r) p[r] = ((r & 3) + 8 * (r >> 2) > lim) ? 0.f : p[r] * rcd; }
                bf16x8 pa0, pa1; RET_PK4(p, 0, pa0); RET_PK4(p, 8, pa1);
                const bf16x8 v0 = *(const LAS bf16x8*)(lds + vrow + (((4 * jb + hi) ^ vx) << 4)), v1 = *(const LAS bf16x8*)(lds + vrow + (((4 * jb + 2 + hi) ^ vx) << 4));
                o = __builtin_amdgcn_mfma_f32_32x32x16_bf16(pa0, v0, o, 0, 0, 0); o = __builtin_amdgcn_mfma_f32_32x32x16_bf16(pa1, v1, o, 0, 0, 0);
                asm volatile("" ::: "memory");
            }
            { float lgn = lg2; asm volatile("" : "+v"(lgn));
              const float e0 = (float)(32 * ib + 4 * hi + 1) * lgn;
              char* ob = (char*)(O + (r0 + 32 * ib + 4 * hi) * RIN + h * RDV + vs * 128 + 32 * vb + r32);
#pragma unroll
              for (int r = 0; r < 16; ++r) { const int cr = (r & 3) + 8 * (r >> 2); const float qd = __builtin_amdgcn_exp2f(fmaf((float)cr, lgn, e0));
                  const float a = o[r] * qd, an = __shfl_xor(a, 1);
                  if ((r32 & 1) == 0) *(unsigned*)(ob + (size_t)cr * RIN * 2) = cvtpk(a, an); } }
            __syncthreads();
            bf16x8 kt[4];
            { typedef short s16x4 __attribute__((ext_vector_type(4)));
              const int l16 = lane & 15, q4 = l16 >> 2, p4 = l16 & 3, chunk = 4 * wid + 2 * ((lane >> 4) & 1) + (p4 >> 1);
#pragma unroll
              for (int h2 = 0; h2 < 2; ++h2) { const int rw = 8 * hi + 4 * h2 + q4; const int off = L_K + rw * 512 + ((chunk ^ rw) << 4) + (p4 & 1) * 8;
#pragma unroll
                  for (int sx = 0; sx < 4; ++sx) { const s16x4 t4 = __builtin_amdgcn_ds_read_tr16_b64_v4i16((LAS s16x4*)(lds + off + sx * 8192));
                      kt[sx][4 * h2 + 0] = t4[0]; kt[sx][4 * h2 + 1] = t4[1]; kt[sx][4 * h2 + 2] = t4[2]; kt[sx][4 * h2 + 3] = t4[3]; } } }
            if (n + 1 < NCH) RET_LOAD(n + 1);
#pragma unroll
            for (int q = 0; q < 4; ++q)
#pragma unroll
                for (int r = 0; r < 16; ++r) Racc[q][r] *= cd;
#pragma unroll
            for (int sx = 0; sx < 4; ++sx) {
#pragma unroll
                for (int q = 0; q < 4; ++q) { const bf16x8 vf = *(const LAS bf16x8*)(lds + L_V + (32 * q + r32) * 128 + (((2 * sx + hi) ^ vx) << 4));
                    Racc[q] = __builtin_amdgcn_mfma_f32_32x32x16_bf16(kt[sx], vf, Racc[q], 0, 0, 0); }
                asm volatile("" ::: "memory"); }
#pragma unroll
            for (int q = 0; q < 4; ++q)
#pragma unroll
                for (int g4 = 0; g4 < 4; ++g4) { const int v = 32 * q + r32; typedef unsigned u32x2 __attribute__((ext_vector_type(2)));
                    const u32x2 w = {cvtpk(Racc[q][4 * g4], Racc[q][4 * g4 + 1]), cvtpk(Racc[q][4 * g4 + 2], Racc[q][4 * g4 + 3])};
                    *(LAS u32x2*)(lds + rtswz(v, 4 * wid + g4) + 8 * hi) = w; }
            __syncthreads();
            if (n + 1 < NCH) { RET_PUT_QK(); RET_PUT_V(); __syncthreads(); }
        }
    }
#undef RET_LOAD
#undef RET_PUT_QK
#undef RET_PUT_V
}
#undef RET_PK4
}
#define RETCORE(raw, kt, vt, o) ret::core_mfma(cx, raw, kt, vt, o)
#define ATTN(mode, q, k, v, o, sm) att::attn_mfma<mode>(cx, q, k, v, o, sm)
#define ATTN_WIN_COMBINE(q, k, v, o, sm, oc, os, gt) att::attn_mfma<2>(cx, q, k, v, o, sm, oc, os, gt)
#else
#define ATTN(mode, q, k, v, o, sm) stage_attn(cx, mode, q, k, v, o, sm)
#define ATTN_WIN_COMBINE(q, k, v, o, sm, oc, os, gt) do { stage_attn(cx, 2, q, k, v, o, sm); stage_nsa_combine_host(cx, o, oc, os, gt); } while (0)
#define RETCORE(raw, kt, vt, o) stage_ret_core(cx, raw, kt, vt, o)
#define S5CORE(u, y, ab, bb, cre, cim, dsk) stage_s5_core(cx, u, y, ab, bb, cre, cim, dsk)
#endif

constexpr int PH_PER_LAYER = 20, N_PHASES = DEPTH * PH_PER_LAYER;
HD bool phase_exists(int ph) {
    const int layer = ph / PH_PER_LAYER, k = ph % PH_PER_LAYER, mx = layer % 3; const bool moe = (layer % 2) == 1;
    if (k == 0) return true;
    if (k >= 1 && k <= 9) { if (mx == 0) return k == 1 || (k >= 4 && k <= 6); if (mx == 1) return k != 8; return k == 1 || k == 3 || k == 4; }
    if (k == 10 || k == 11 || k == 12) return true;
    if (k == 13) return moe;
    if (k == 14 || k == 16) return true;
    return false;
}
#ifdef HOST_SIM
#define GRID_BAR() ((void)0)
#endif
#ifndef PHMASK
#define PHMASK 0xFFFFFFu
#endif
#ifndef MXMASK
#define MXMASK 7
#endif
#ifndef FFMASK
#define FFMASK 3
#endif
#define MX_ON(i) ((MXMASK >> (i)) & 1)
#define FF_ON(i) ((FFMASK >> (i)) & 1)
#ifdef HOST_SIM
#define FRESH_CTX() const Ctx& cx = cx0
#else
#define FRESH_CTX() Ctx cx = cx0; { unsigned l_ = (unsigned)(unsigned long long)cx.lds; unsigned long long w_ = (unsigned long long)cx.ws; int wv_ = cx0.wave; asm volatile("" : "+s"(wv_), "+s"(l_), "+s"(w_), "+s"(cx.bid), "+s"(cx.nblk)); \
    int ln_; asm volatile("v_mbcnt_lo_u32_b32 %0, -1, 0\n\tv_mbcnt_hi_u32_b32 %0, -1, %0" : "=v"(ln_)); \
    cx.lds = (LAS unsigned char*)l_; cx.ws = (unsigned char*)(__attribute__((address_space(1))) unsigned char*)w_; cx.lane = ln_; cx.wave = wv_; cx.tid = wv_ * 64 + ln_; }
#endif
#ifdef HOST_SIM
#define OPAQUE_S(x) ((void)0)
#else
#define OPAQUE_S(x) asm volatile("" : "+s"(x))
#endif
#ifndef DIAG
#define DIAG 0
#endif
HD bool diag_rep(int k, int mx, bool moe) {
    if (DIAG == 1) return k == 0;
    if (DIAG == 2) return (k == 1) || (mx == 1 && k == 3) || (!moe && k == 11) || (moe && (k == 12 || k == 13));
    if (DIAG == 3) return (mx == 0 && (k == 4)) || (mx == 1 && (k == 2 || k == 4 || k == 5 || k == 6 || k == 7)) || (mx == 2 && k == 3);
    if (DIAG == 4) return !moe && (k == 10 || k == 14);
    if (DIAG == 5) return mx == 0 && k == 4;
    if (DIAG == 6) return mx == 1 && (k == 2 || k == 4);
    if (DIAG == 7) return mx == 1 && (k == 5 || k == 6 || k == 7);
    if (DIAG == 8) return mx == 2 && k == 3;
    if (DIAG == 11) return mx == 0 && k == 1;
    if (DIAG == 12) return moe && k == 12;
    if (DIAG == 13) return moe && k == 13;
    if (DIAG == 14) return !moe && k == 11;
    if (DIAG == 19) return mx == 1 && k == 6;
    if (DIAG == 20) return mx == 1 && k == 7;
    if (DIAG == 21) return mx == 1 && k == 5;
    if (DIAG == 16) return mx == 1 && k == 4;
    if (DIAG == 17) return mx == 1 && k == 2;
    return false;
}
#if DIAG
#define PHASE_S(k, ...) do { int _id = base + (k); OPAQUE_S(_id); if (((PHMASK >> (k)) & 1u) && lo <= _id && _id < hi) { int nrep_ = (DIAG == 10) ? 3 : 1; OPAQUE_S(nrep_); \
    for (int rep_ = 0; rep_ < nrep_; ++rep_) { { FRESH_CTX(); const float SG = rep_ == 2 ? -1.0f : 1.0f; __VA_ARGS__; } if (rep_ + 1 < nrep_) { GRID_BAR(); } } if (_id + 1 < hi) { GRID_BAR(); } } } while (0)
#define PHASE(k, ...) do { int _id = base + (k); OPAQUE_S(_id); if (((PHMASK >> (k)) & 1u) && lo <= _id && _id < hi) { int nrep_ = diag_rep((k), mx, moe) ? 2 : 1; OPAQUE_S(nrep_); \
    for (int rep_ = 0; rep_ < nrep_; ++rep_) { { FRESH_CTX(); __VA_ARGS__; } if (rep_ + 1 < nrep_) { GRID_BAR(); } } if (_id + 1 < hi) { GRID_BAR(); } } } while (0)
#else
#define PHASE_S(k, ...) do { int _id = base + (k); OPAQUE_S(_id); if (((PHMASK >> (k)) & 1u) && lo <= _id && _id < hi) { { FRESH_CTX(); const float SG = 1.0f; __VA_ARGS__; } if (_id + 1 < hi) { GRID_BAR(); } } } while (0)
#define PHASE(k, ...) do { int _id = base + (k); OPAQUE_S(_id); if (((PHMASK >> (k)) & 1u) && lo <= _id && _id < hi) { { FRESH_CTX(); __VA_ARGS__; } if (_id + 1 < hi) { GRID_BAR(); } } } while (0)
#endif

#ifdef HOST_SIM
inline void program(const Ctx& cx0, const Args& args)
#else
#define XB_TMO      128
#define XB_XCNT(j)  (256  + 64 * (j))
#define XB_XSUB(j)  (1280 + 64 * (j))
#define XB_XGEN(j)  (2304 + 64 * (j))
#define XB_TOP      3328
#define XB_TOPGEN   3392
#define XCD_BAR_WORDS 3456
#define XB_SPIN_CAP (1u << 22)
__device__ __forceinline__ unsigned xb_ld(unsigned* p)              { return __hip_atomic_load(p, __ATOMIC_RELAXED, __HIP_MEMORY_SCOPE_AGENT); }
__device__ __forceinline__ unsigned xb_add(unsigned* p, unsigned v) { return __hip_atomic_fetch_add(p, v, __ATOMIC_RELAXED, __HIP_MEMORY_SCOPE_AGENT); }
__device__ __forceinline__ unsigned xb_xcc_id() { return (unsigned)__builtin_amdgcn_s_getreg((3 << 11) | 20) & 0xFu; }
#define XB_SPIN(cond, bar) do { unsigned _sp = 0; while (cond) { __builtin_amdgcn_s_sleep(1); \
    if ((++_sp & 255u) == 0u) { if (xb_ld(&(bar)[XB_TMO])) break; if (_sp > XB_SPIN_CAP) { atomicAdd(&(bar)[XB_TMO], 1u); break; } } } } while (0)
struct XcdBarrier { unsigned* bar; unsigned x; volatile LAS unsigned* st; };
__device__ __forceinline__ XcdBarrier xcd_barrier_post(unsigned* bar, volatile LAS unsigned* st, bool leader) {
    XcdBarrier b; b.bar = bar; b.x = xb_xcc_id(); b.st = st;
    if (leader) (void)xb_add(&bar[XB_XCNT(b.x)], 1u);
    return b;
}
__device__ __forceinline__ void xcd_barrier_complete(unsigned* bar, unsigned x, unsigned& nloc, unsigned& nx) {
    const unsigned G = gridDim.x * gridDim.y * gridDim.z;
    unsigned sum, cnt, mine, sp = 0u;
    for (;;) {
        sum = 0u; cnt = 0u; mine = 0u;
#pragma unroll
        for (unsigned j = 0; j < 16; ++j) { const unsigned c = xb_ld(&bar[XB_XCNT(j)]); sum += c; cnt += (c > 0u) ? 1u : 0u; mine = (j == x) ? c : mine; }
        if (sum == G) break;
        __builtin_amdgcn_s_sleep(1);
        if ((++sp & 255u) == 0u) { if (xb_ld(&bar[XB_TMO])) break; if (sp > XB_SPIN_CAP) { atomicAdd(&bar[XB_TMO], 1u); break; } }
    }
    nloc = mine > 0u ? mine : 1u; nx = cnt > 0u ? cnt : 1u;
}
__device__ __forceinline__ void xcd_barrier(const XcdBarrier& b, bool leader) {
    asm volatile("s_waitcnt vmcnt(0)" ::: "memory");
    __syncthreads();
    if (leader) {
        unsigned* bar = b.bar;
        __builtin_amdgcn_s_waitcnt(0);
        unsigned nloc = b.st[0], nx = b.st[1];
        if (nloc == 0u) { xcd_barrier_complete(bar, b.x, nloc, nx); b.st[0] = nloc; b.st[1] = nx; }
        const unsigned old = xb_add(&bar[XB_XSUB(b.x)], 1u);
        const unsigned gen = old / nloc;
        if (old + 1u == (gen + 1u) * nloc) {
            __builtin_amdgcn_fence(__ATOMIC_RELEASE, "agent");
            asm volatile("s_waitcnt vmcnt(0)" ::: "memory");
            const unsigned og = xb_add(&bar[XB_TOP], 1u);
            const unsigned tg = og / nx;
            if (og + 1u == (tg + 1u) * nx) xb_add(&bar[XB_TOPGEN], 1u);
            else XB_SPIN(xb_ld(&bar[XB_TOPGEN]) == tg, bar);
            __builtin_amdgcn_fence(__ATOMIC_ACQUIRE, "agent");
            xb_add(&bar[XB_XGEN(b.x)], 1u);
            asm volatile("s_waitcnt vmcnt(0)" ::: "memory");
        } else {
            XB_SPIN(xb_ld(&bar[XB_XGEN(b.x)]) == gen, bar);
            __builtin_amdgcn_fence(__ATOMIC_ACQUIRE, "agent");
            asm volatile("s_waitcnt vmcnt(0)" ::: "memory");
        }
    }
    __syncthreads();
}
#define GRID_BAR() do { int ln_; asm volatile("v_mbcnt_lo_u32_b32 %0, -1, 0\n\tv_mbcnt_hi_u32_b32 %0, -1, %0" : "=v"(ln_)); xcd_barrier(bar, cx0.wave == 0 && ln_ == 0); } while (0)
__global__ void __launch_bounds__(NT, 2) trunk_fwd(Args args)
#endif
{
#ifndef HOST_SIM
    extern __shared__ __attribute__((aligned(16))) unsigned char lds_raw[];
    Ctx cx0; cx0.lds = (LAS unsigned char*)lds_raw; cx0.tid = threadIdx.x; cx0.lane = cx0.tid & 63; { int w0_ = __builtin_amdgcn_readfirstlane(cx0.tid >> 6); asm volatile("" : "+s"(w0_)); cx0.wave = w0_; } cx0.bid = blockIdx.x; cx0.nblk = gridDim.x; cx0.ws = args.ws;
    volatile LAS unsigned* misc = (volatile LAS unsigned*)(cx0.lds + LDS_MISC);
    if (cx0.tid < 32) misc[cx0.tid] = 0u;
    if (cx0.tid == 0) { LAS unsigned long long* tab = (LAS unsigned long long*)(cx0.lds + LDS_TAB);
#pragma unroll
        for (int i = 0; i < N_INPUTS; ++i) tab[i] = (unsigned long long)args.in[i];
        tab[N_INPUTS] = (unsigned long long)args.out; }
    __syncthreads();
    XcdBarrier bar = xcd_barrier_post((unsigned*)(args.ws + OFF_CTL) + CW_BAR, misc + 8, cx0.tid == 0);
#endif
    const int lo = args.ph_lo, hi = args.ph_hi;
#define WSP(type, off) ((type*)(cx.ws + (off)))
#define Hm WSP(bf16, OFF_H + (size_t)(layer & 1) * T * D * 2)
#define Hn WSP(bf16, OFF_H + (size_t)((layer & 1) ^ 1) * T * D * 2)
#define RINV WSP(float, OFF_RINV)
#define SSQB WSP(float, OFF_SSQ)
#define XN WSP(bf16, OFF_XN)
#define PB WSP(bf16, OFF_PB)
#define PROJ WSP(bf16, OFF_PROJ)
#define TOPI WSP(int, OFF_TOPI)
#define TOPW WSP(float, OFF_TOPW)
#define SLOT WSP(int, OFF_SLOT)
#define ROWS WSP(int, OFF_ROWS)
#define CMPB WSP(float, OFF_CMPB)
#define S5AB WSP(float, OFF_S5AB)
#define S5BB WSP(float, OFF_S5BB)
#define SELM WSP(unsigned, OFF_SELM)
#define GT WSP(float, OFF_GT)
#define SCRP(type, off) WSP(type, OFF_SCR + (off))
#define RAW_R SCRP(bf16, SC_RET_RAW)
#define O_R (RAW_R + 2 * RH * RDK)
#define KT_R SCRP(bf16, SC_RET_KT)
#define VT_R SCRP(bf16, SC_RET_VT)
#define RAW_N SCRP(bf16, SC_N_RAW)
#define QN SCRP(bf16, SC_N_QN)
#define KS SCRP(bf16, SC_N_KS)
#define VS SCRP(bf16, SC_N_VS)
#define KW SCRP(bf16, SC_N_KW)
#define VW SCRP(bf16, SC_N_VW)
#define KCR SCRP(bf16, SC_N_KCR)
#define VCR SCRP(bf16, SC_N_VCR)
#define HID SCRP(bf16, SC_N_HID)
#define KC SCRP(bf16, SC_N_KC)
#define VC SCRP(bf16, SC_N_VC)
#define OC SCRP(bf16, SC_N_OC)
#define OS SCRP(bf16, SC_N_OS)
#define OW SCRP(bf16, SC_N_OW)
#define U_S SCRP(bf16, SC_S5_U)
#define Y_S SCRP(bf16, SC_S5_Y)
#define ACT_F SCRP(bf16, SC_FFN_ACT)
#define ACT_M SCRP(bf16, SC_MOE_ACT)
#define Y_M SCRP(bf16, SC_MOE_Y)
#define POS ((const int*)IN(I_POS))
#define CNT (WSP(int, OFF_CTL) + CW_MOE + fj * 64)
#define CNT2 (CNT + 16)

#pragma nounroll
    for (int layer = 0; layer < DEPTH; ++layer) {
        const int base = layer * PH_PER_LAYER, mx = layer % 3, mj = layer / 3, fj = layer / 2; const bool moe = (layer % 2) == 1;
        PHASE(0, {
            if (mx == 0) { prep_transpose(cx, IN(I_RWIN) + (size_t)mj * D * RIN, D, RIN, WSP(bf16, OFF_W_RIN), RIN, 0, 0, 0.f, IN(I_NMIX) + (size_t)layer * D);
                           prep_transpose(cx, IN(I_RWOUT) + (size_t)mj * RVW * D, RVW, D, WSP(bf16, OFF_W_ROUT), D, 0, 0); }
            else if (mx == 1) { prep_transpose(cx, IN(I_NWIN) + (size_t)mj * D * NSA_IN, D, NSA_IN, WSP(bf16, OFF_W_NIN), NSA_INP, 0, 0, 0.f, IN(I_NMIX) + (size_t)layer * D);
                           for (int kv = 0; kv < 2; ++kv) prep_transpose(cx, IN(I_NCW1) + ((size_t)mj * 2 + kv) * CK * CHID, CK, CHID, WSP(bf16, OFF_W_CMP) + (size_t)kv * CHID * CK, CHID, 0, 0);
                           prep_transpose(cx, IN(I_NWOUT) + (size_t)mj * D * D, D, D, WSP(bf16, OFF_W_NOUT), D, 0, 0);
                           stage_cmp_bias_part(cx, IN(I_NCPOS) + (size_t)mj * 2 * CK, IN(I_NCW1) + (size_t)mj * 2 * CK * CHID, (float*)HID  ); PREP_W2T(IN(I_NCW2) + (size_t)mj * 2 * CHID * NDH, WSP(bf16, OFF_W_CMP2)); }
            else { prep_transpose(cx, IN(I_SWIN) + (size_t)mj * D * D, D, D, WSP(bf16, OFF_W_SIN), D, 0, 0, 0.f, IN(I_NMIX) + (size_t)layer * D);
                   prep_transpose(cx, IN(I_SWGLU) + (size_t)mj * D * 2 * D, D, 2 * D, WSP(bf16, OFF_W_SGLU), 2 * D, 1, D);
                   stage_s5_prep(cx, IN(I_SARE) + (size_t)mj * SG * SP, IN(I_SAIM) + (size_t)mj * SG * SP, IN(I_SBRE) + (size_t)mj * SG * SP * SGC, IN(I_SBIM) + (size_t)mj * SG * SP * SGC,
                                 IN(I_SLDT) + (size_t)mj * SG, S5AB, S5BB); }
            if (!moe) { if ((GU8_MASK >> layer) & 1u) prep_transpose(cx, IN(I_FWGU) + (size_t)fj * D * 2 * DFF, D, 2 * DFF, WSP(bf16, OFF_W_FGU), 2 * DFF, 1, DFF, F8S_WGU);
                        else prep_transpose(cx, IN(I_FWGU) + (size_t)fj * D * 2 * DFF, D, 2 * DFF, WSP(bf16, OFF_W_FGU), 2 * DFF, 1, DFF, 0.f, IN(I_NFFN) + (size_t)layer * D);
                        prep_transpose(cx, IN(I_FWDN) + (size_t)fj * DFF * D, DFF, D, WSP(bf16, OFF_W_FDN), D, 0, 0, ((DN8_MASK >> layer) & 1u) ? F8S_WDN : 0.f); }
            else { prep_transpose_multi(cx, IN(I_MWGU) + (size_t)fj * NE * D * 2 * DFE, (size_t)D * 2 * DFE, NE, D, 2 * DFE, WSP(bf16, OFF_W_MGU), (size_t)2 * DFE * D, 2 * DFE, 1, DFE, F8S_WGU);
                   prep_transpose_multi(cx, IN(I_MWDN) + (size_t)fj * NE * DFE * D, (size_t)DFE * D, NE, DFE, D, WSP(bf16, OFF_W_MDN), (size_t)D * DFE, D, 0, 0, F8S_WDN); }
            prep_transpose(cx, IN(I_PWPROJ) + (size_t)layer * PLE * D, PLE, D, WSP(bf16, OFF_W_PPROJ), D, 0, 0);
            prep_transpose(cx, IN(I_PWGATE) + (size_t)layer * D * D, D, D, WSP(bf16, OFF_W_PGATE), D, 0, 0, 0.f, IN(I_NPLE) + (size_t)layer * D);
            if (layer == 0) stage_norm(cx, IN(I_X), Hm, Hm, IN(I_NMIX) + (size_t)layer * D, nullptr, nullptr, nullptr, nullptr, nullptr, nullptr, nullptr, nullptr, RINV);
            else stage_rinv(cx, SSQB, D / BN * 4, RINV);
            stage_p2b(cx, IN(I_P) + (size_t)layer * T * PLE, PB);
        });
        if (DIAG == 9) { for (int xb_ = 0; xb_ < 10; ++xb_) { GRID_BAR(); } }
        if (MX_ON(0) && mx == 0) {

            PHASE(1, { SchedDense sc{Hm, (const bf16*)WSP(bf16, OFF_W_RIN), D, D, T / BMR, RIN / BN, cx.nblk, cx.bid}; gemm_run(cx, D, D, D, sc, ERetIn{RAW_R, KT_R, VT_R, POS, RINV}); });
            PHASE(4, { RETCORE(RAW_R, KT_R, VT_R, O_R); });
            PHASE(5, { stage_ret_norm(cx, O_R, RAW_R, IN(I_RGN) + (size_t)mj * RVW, VT_R); });
            PHASE_S(6, { SchedDense sc{VT_R, (const bf16*)WSP(bf16, OFF_W_ROUT), RVW, RVW, T / BMR, D / BN, cx.nblk, cx.bid}; gemm_run(cx, RVW, RVW, RVW, sc, EResAdd{Hm, SG, SSQB}); });
        } else if (MX_ON(1) && mx == 1) {


            PHASE(1, { SchedDense sc{Hm, (const bf16*)WSP(bf16, OFF_W_NIN), D, D, T / BMR, NSA_INP / BN, cx.nblk, cx.bid}; gemm_run(cx, D, D, D, sc, EStoreBf16R{RAW_N, NSA_INP, RINV}); });
            PHASE(2, { NSAPREP1(RAW_N, POS, IN(I_NQN) + (size_t)mj * NDH, IN(I_NKN) + (size_t)mj * 3 * NDH, QN, KS, VS, KW, VW, KCR, VCR, GT);
                       stage_transpose_cols2(cx, RAW_N, NSA_INP, D + 3 * KVW, D + 5 * KVW, KVW, VS, VW); stage_cmp_bias_red(cx, (const float*)HID, CMPB); });
            PHASE(3, { SchedCmp sc{KCR, VCR, (const bf16*)WSP(bf16, OFF_W_CMP), cx.nblk, cx.bid}; gemm_run(cx, CLDA, CK, CK, sc, ECmp{HID, CMPB}); });
            PHASE(4, { CMP2(HID, IN(I_NCW2) + (size_t)mj * 2 * CHID * NDH, (const bf16*)WSP(bf16, OFF_W_CMP2), IN(I_NKN) + (size_t)mj * 3 * NDH, POS, KC, VC); });
            PHASE(5, { ATTN(0, QN, KC, VC, OC, SELM); });
            PHASE(6, { ATTN(1, QN, KS, VS, OS, SELM); });
            PHASE(7, { ATTN_WIN_COMBINE(QN, KW, VW, OW, SELM, OC, OS, GT); });
            PHASE_S(9, { SchedDense sc{OW, (const bf16*)WSP(bf16, OFF_W_NOUT), D, D, T / BMR, D / BN, cx.nblk, cx.bid}; gemm_run(cx, D, D, D, sc, EResAdd{Hm, SG, SSQB}); });
        } else if (MX_ON(2) && mx == 2) {

            PHASE(1, { SchedDense sc{Hm, (const bf16*)WSP(bf16, OFF_W_SIN), D, D, T / BMR, D / BN, cx.nblk, cx.bid}; gemm_run(cx, D, D, D, sc, EStoreBf16R{U_S, D, RINV}); });
            PHASE(3, { S5CORE(U_S, Y_S, S5AB, S5BB, IN(I_SCRE) + (size_t)mj * SG * SGC * SP, IN(I_SCIM) + (size_t)mj * SG * SGC * SP, IN(I_SD) + (size_t)mj * D); });
            PHASE_S(4, { SchedDense sc{Y_S, (const bf16*)WSP(bf16, OFF_W_SGLU), D, D, T / BMR, 2 * D / BN, cx.nblk, cx.bid}; gemm_run(cx, D, D, D, sc, EGlu{Hm, SG, SSQB}); });
        }
#define PLE_PROJ() do { SchedDense scp{PB, (const bf16*)WSP(bf16, OFF_W_PPROJ), PLE, PLE, T / BMR, D / BN, cx.nblk, cx.bid}; gemm_run(cx, PLE, PLE, PLE, scp, EStoreBf16{PROJ, D}); } while (0)
        if (FF_ON(0) && !moe) {

            const bool gu8 = ((GU8_MASK >> layer) & 1u) != 0u;
            PHASE(10, { if (gu8) stage_norm(cx, nullptr, Hm, nullptr, IN(I_NFFN) + (size_t)layer * D, nullptr, nullptr, nullptr, nullptr, nullptr, nullptr, nullptr, nullptr, nullptr, (fp8*)XN);
                        else stage_rinv(cx, SSQB, mx == 2 ? D / IB * 4 : D / BN * 4, RINV); });
            const bool dn8 = ((DN8_MASK >> layer) & 1u) != 0u;
            PHASE(11, { if (gu8) { SchedDense sc8{XN, (const bf16*)WSP(bf16, OFF_W_FGU), D / 2, D / 2, T / BMR, 2 * DFF / BN, cx.nblk, cx.bid}; gemm_run<true>(cx, D, D, D, sc8, ESwiGLU8{(fp8*)ACT_F, DFF, 1.0f / (F8S_X * F8S_WGU)}); }
                        else { SchedDense sc{Hm, (const bf16*)WSP(bf16, OFF_W_FGU), D, D, T / BMR, 2 * DFF / BN, cx.nblk, cx.bid};
                        if (dn8) gemm_run(cx, D, D, D, sc, ESwiGLU8R{(fp8*)ACT_F, DFF, RINV}); else gemm_run(cx, D, D, D, sc, ESwiGLU{ACT_F, DFF, RINV}); } });
            PHASE_S(12, { if (dn8) { SchedDense sc{ACT_F, (const bf16*)WSP(bf16, OFF_W_FDN), DFF / 2, DFF / 2, T / BMR, D / BN, cx.nblk, cx.bid};
                              gemm_run<true>(cx, DFF, DFF, DFF, sc, EResAdd{Hm, SG * (1.0f / (F8S_ACT * F8S_WDN)), SSQB}); }
                          else { SchedDense sc{ACT_F, (const bf16*)WSP(bf16, OFF_W_FDN), DFF, DFF, T / BMR, D / BN, cx.nblk, cx.bid}; gemm_run(cx, DFF, DFF, DFF, sc, EResAdd{Hm, SG, SSQB}); } });
            PHASE(14, { stage_rinv(cx, SSQB, D / BN * 4, RINV); PLE_PROJ(); });
        } else if (FF_ON(1) && moe) {

            PHASE(10, { stage_norm(cx, nullptr, Hm, nullptr, IN(I_NFFN) + (size_t)layer * D, XN, nullptr, nullptr, nullptr, IN(I_MROUTER) + (size_t)fj * D * NE, TOPI, TOPW, CNT); });
            PHASE(11, { stage_moe_assign(cx, TOPI, SLOT, XN, Y_M, CNT, CNT2); });
            PHASE(12, { SchedMoE<false> sc; sc.A = Y_M; sc.W = (const bf16*)WSP(bf16, OFF_W_MGU); sc.rows = nullptr; sc.lda = D / 2; sc.wstride = 2 * DFE * D / 2; sc.ldb = D / 2; sc.nN = 2 * DFE / BN; sc.G = cx.nblk; sc.c = cx.bid; sc.init(CNT);
                               gemm_run<true>(cx, D, D, D, sc, ESwiGLU8{(fp8*)ACT_M, DFE, 1.0f / (F8S_X * F8S_WGU)}); });
            PHASE(13, { SchedMoE<false> sc; sc.A = ACT_M; sc.W = (const bf16*)WSP(bf16, OFF_W_MDN); sc.rows = nullptr; sc.lda = DFE / 2; sc.wstride = D * DFE / 2; sc.ldb = DFE / 2; sc.nN = D / BN; sc.G = cx.nblk; sc.c = cx.bid; sc.init(CNT);
                               gemm_run<true>(cx, DFE, DFE, DFE, sc, EStoreBf16S{Y_M, D, 1.0f / (F8S_ACT * F8S_WDN)});
                               { const int w0 = (sc.tl[NE] * sc.nN) % cx.nblk; const bool restr = w0 > 0 && w0 <= cx.nblk / 2;
                                 SchedDense scp{PB, (const bf16*)WSP(bf16, OFF_W_PPROJ), PLE, PLE, T / BMR, D / BN, restr ? cx.nblk - w0 : cx.nblk, restr ? cx.bid - w0 : cx.bid}; gemm_run(cx, PLE, PLE, PLE, scp, EStoreBf16{PROJ, D}); } });
            PHASE(14, { stage_norm(cx, nullptr, Hm, Hm, IN(I_NPLE) + (size_t)layer * D, nullptr, Y_M, SLOT, TOPW, nullptr, nullptr, nullptr, nullptr, RINV); });
        }
        PHASE_S(16, { SchedDense sc{Hm, (const bf16*)WSP(bf16, OFF_W_PGATE), D, D, T / BMR, D / BN, cx.nblk, cx.bid}; gemm_run(cx, D, D, D, sc, EPle{Hm, (layer == DEPTH - 1) ? (bf16*)nullptr : Hn, (layer == DEPTH - 1) ? OUTP : (float*)nullptr, PROJ, SG, RINV, SSQB});
            if (DIAG == 10 && layer == DEPTH - 1 && SG < 0.f) { GRID_BAR(); gemm_run(cx, D, D, D, sc, EPle{Hm, nullptr, OUTP, PROJ, 0.0f, RINV, SSQB}); } });
    }
}

#ifndef HOST_SIM
#ifndef ONE_LAUNCH
#define ONE_LAUNCH 1
#endif
extern "C" void kernel_launch(void* const* d_in, const int* in_sizes, int n_in, void* d_out, int out_size, void* d_ws, size_t ws_size, hipStream_t stream) {
    static int grid = 0;
    if (grid == 0) {
        if (n_in != N_INPUTS || out_size != T * D || ws_size < WS_NEED) { fprintf(stderr, "kernel_launch: shape/workspace mismatch (n_in %d out %d ws %zu need %zu)\n", n_in, out_size, ws_size, (size_t)WS_NEED); grid = -1; return; }
        int dev = 0, cus = 0, per_cu = 0;
        if (hipGetDevice(&dev) != hipSuccess || hipDeviceGetAttribute(&cus, hipDeviceAttributeMultiprocessorCount, dev) != hipSuccess) { grid = -1; return; }
        if (hipFuncSetAttribute((const void*)trunk_fwd, hipFuncAttributeMaxDynamicSharedMemorySize, LDS_BYTES) != hipSuccess) { fprintf(stderr, "kernel_launch: hipFuncSetAttribute failed\n"); grid = -1; return; }
        if (hipOccupancyMaxActiveBlocksPerMultiprocessor(&per_cu, (const void*)trunk_fwd, NT, LDS_BYTES) != hipSuccess || per_cu < 1) fprintf(stderr, "kernel_launch: occupancy query says %d\n", per_cu);
        (void)hipGetLastError();
        grid = cus;
    }
    if (grid < 0) return;
    (void)hipMemsetAsync((char*)d_ws + OFF_CTL, 0, CTL_BYTES, stream);
    Args a{};
    for (int i = 0; i < N_INPUTS; ++i) a.in[i] = (const float*)d_in[i];
    a.out = (float*)d_out; a.ws = (unsigned char*)d_ws;
#if ONE_LAUNCH
    a.ph_lo = 0; a.ph_hi = N_PHASES;
    hipLaunchKernelGGL(trunk_fwd, dim3(grid), dim3(NT), LDS_BYTES, stream, a);
#else
    for (int ph = 0; ph < N_PHASES; ++ph) { if (!phase_exists(ph)) continue; a.ph_lo = ph; a.ph_hi = ph + 1; hipLaunchKernelGGL(trunk_fwd, dim3(grid), dim3(NT), LDS_BYTES, stream, a); }
#endif
}
#endif
```

```cpp
#ifndef HOST_SIM
#include <hip/hip_runtime.h>
#endif
#include <cstdio>
#include <cstdint>
#include <cmath>
#include <cstring>

#ifdef SMALL
constexpr int D = 128, NB = 2, S = 2048, PLE = 32, RH = 2, RC = 64, NH = 8, NG = 2, CL = 32, CSTR = 16, SELB = 64, TOPN = 16, WIN = 512,
              CHID = 64, SGC = 16, SP = 64, DFF = 352, NE = 8, DFE = 448, IB = 32, BN = 64, PT_K = 32;
#else
constexpr int D = 1024, NB = 16, S = 2048, PLE = 256, RH = 4, RC = 64, NH = 8, NG = 2, CL = 32, CSTR = 16, SELB = 64, TOPN = 16, WIN = 512,
              CHID = 256, SGC = 16, SP = 64, DFF = 2816, NE = 8, DFE = 3584, IB = 128, BN = 256, PT_K = 64;
#endif
constexpr int T = NB * S, DEPTH = 4, BMR = 256;
constexpr float NORM_EPS = 1e-6f, ROPE_LN_THETA = 9.210340371976184f;
constexpr int RDK = D / RH, RDV = 2 * RDK, RIN = 2 * RH * RDK + 2 * RH * RDV, RVW = RH * RDV;
constexpr int NDH = D / NH, HG = NH / NG, KVW = NG * NDH, NSA_IN = NH * NDH + 6 * KVW + 3 * NH, NSA_INP = ((NSA_IN + BN - 1) / BN) * BN;
constexpr int NCB = S / CSTR, NCV = (S - CL) / CSTR + 1, NSEL = S / SELB, CK = CL * NDH, CLDA = CSTR * NDH, CMP_M = NB * NG * NCB;
constexpr int SG = D / SGC;
constexpr int MOE_ROWS = 2 * T + NE * BMR;
constexpr int NT = 512, NWV = 8;
static_assert(BN == 2 * IB && DFF % IB == 0 && DFE % IB == 0 && D % IB == 0 && RDK == BN, "gated interleave / one retention head per column tile");
static_assert(NSEL <= 32 && NCV <= 128 && CHID == BN && T % BMR == 0 && CMP_M % BMR == 0, "shape assumptions");

typedef unsigned short bf16;
#ifdef HOST_SIM
#define HD inline
#define DEV inline
#else
#define HD __host__ __device__ __forceinline__
#define DEV __device__ __forceinline__
#endif
struct alignas(16) F4 { float x, y, z, w; };
struct alignas(16) U4 { unsigned x, y, z, w; };
struct alignas(8) U2 { unsigned x, y; };
HD float bf2f(bf16 b) { unsigned u = (unsigned)b << 16; return __builtin_bit_cast(float, u); }
#ifdef HOST_SIM
HD bf16 f2bf(float f) { unsigned u = __builtin_bit_cast(unsigned, f); u += 0x7fffu + ((u >> 16) & 1u); return (bf16)(u >> 16); }
HD unsigned pk2(float lo, float hi) { return (unsigned)f2bf(lo) | ((unsigned)f2bf(hi) << 16); }
#else
__device__ __forceinline__ unsigned pk2(float lo, float hi) { unsigned r; asm("v_cvt_pk_bf16_f32 %0, %1, %2" : "=v"(r) : "v"(lo), "v"(hi)); return r; }
__device__ __forceinline__ bf16 f2bf(float f) { return (bf16)(pk2(f, f) & 0xffffu); }
#endif
#ifdef HOST_SIM
HD float fexp2_(float x) { return exp2f(x); }
HD float flog2_(float x) { return log2f(x); }
#else
HD float fexp2_(float x) { return __builtin_amdgcn_exp2f(x); }
HD float flog2_(float x) { return __builtin_amdgcn_logf(x); }
#endif
HD void rope_cs_(float pos, int i2, int d, float& cs, float& sn) {
#ifdef HOST_SIM
    const float inv = expf(-(float)i2 / (float)d * ROPE_LN_THETA), ang = pos * inv; cs = cosf(ang); sn = sinf(ang);
#else
    const float inv = __builtin_amdgcn_exp2f(-(float)i2 / (float)d * 13.287712379549449f);
    const float rev = __builtin_amdgcn_fractf(pos * inv * 0.15915494309189535f); cs = __builtin_amdgcn_cosf(rev); sn = __builtin_amdgcn_sinf(rev);
#endif
}
HD float log2_gamma_(int h) { return flog2_(1.0f - fexp2_(-5.0f - (float)h)); }
typedef unsigned char fp8;
#ifndef GU8_MASK
#define GU8_MASK 0x4u
#endif
#ifndef DN8_MASK
#define DN8_MASK 0x4u
#endif
static_assert((GU8_MASK & ~DN8_MASK) == 0, "fp8 gate-up needs the fp8 down-projection");
constexpr float F8S_X = 8.0f, F8S_WGU = 128.0f, F8S_ACT = 8.0f, F8S_WDN = 256.0f;
HD float f82f(fp8 v) { const int e = (v >> 3) & 15, m = v & 7; const float r = e ? ldexpf(1.0f + (float)m * 0.125f, e - 7) : ldexpf((float)m * 0.125f, -6); return (v & 0x80) ? -r : r; }
HD fp8 f2f8_sw(float x) {
    const unsigned sgn = x < 0.f ? 0x80u : 0u; float a = fabsf(x); if (!(a < 448.0f)) return (fp8)(sgn | 0x7Eu);
    if (a < 0.015625f) return (fp8)(sgn | (unsigned)rintf(a * 512.0f));
    int ex; (void)frexpf(a, &ex); int eu = ex - 1; int m = (int)rintf((ldexpf(a, -eu) - 1.0f) * 8.0f); if (m == 8) { m = 0; ++eu; }
    unsigned code = ((unsigned)(eu + 7) << 3) | (unsigned)m; if (code > 0x7Eu) code = 0x7Eu; return (fp8)(sgn | code); }
#ifdef HOST_SIM
HD unsigned pk4_f8(float a, float b, float c, float d) { return (unsigned)f2f8_sw(a) | ((unsigned)f2f8_sw(b) << 8) | ((unsigned)f2f8_sw(c) << 16) | ((unsigned)f2f8_sw(d) << 24); }
#else
__device__ __forceinline__ float clamp448_(float x) { return __builtin_amdgcn_fmed3f(x, -448.0f, 448.0f); }
__device__ __forceinline__ unsigned pk4_f8(float a, float b, float c, float d) { int w = __builtin_amdgcn_cvt_pk_fp8_f32(clamp448_(a), clamp448_(b), 0, false); w = __builtin_amdgcn_cvt_pk_fp8_f32(clamp448_(c), clamp448_(d), w, true); return (unsigned)w; }
#endif
#ifdef HOST_SIM
HD float sigmoidf_(float x) { return 1.0f / (1.0f + expf(-x)); }
HD float geluf_(float x) { return 0.5f * x * (1.0f + tanhf(0.7978845608028654f * (x + 0.044715f * x * x * x))); }
#else
HD float sigmoidf_(float x) { return __builtin_amdgcn_rcpf(1.0f + __builtin_amdgcn_exp2f(-1.4426950408889634f * x)); }
HD float geluf_(float x) { const float u2 = 1.5957691216057308f * (x + 0.044715f * x * x * x); return x * sigmoidf_(u2); }
#endif
HD float siluf_(float x) { return x * sigmoidf_(x); }

constexpr size_t al256(size_t x) { return (x + 255) & ~(size_t)255; }
constexpr size_t OFF_CTL = 0, CTL_BYTES = 1u << 20;
constexpr size_t OFF_H = CTL_BYTES;
constexpr size_t OFF_XN = OFF_H + al256((size_t)T * D * 4);
constexpr size_t OFF_PB = OFF_XN + al256((size_t)T * D * 2);
constexpr size_t OFF_PROJ = OFF_PB + al256((size_t)T * PLE * 2);
constexpr size_t OFF_TOPI = OFF_PROJ + al256((size_t)T * D * 2);
constexpr size_t OFF_TOPW = OFF_TOPI + al256((size_t)T * 2 * 4);
constexpr size_t OFF_SLOT = OFF_TOPW + al256((size_t)T * 2 * 4);
constexpr size_t OFF_ROWS = OFF_SLOT + al256((size_t)T * 2 * 4);
constexpr size_t OFF_CMPB = OFF_ROWS + al256((size_t)MOE_ROWS * 4);
constexpr size_t OFF_S5AB = OFF_CMPB + al256((size_t)2 * CHID * 4);
constexpr size_t OFF_S5BB = OFF_S5AB + al256((size_t)SG * SP * 4 * 4);
constexpr size_t OFF_SELM = OFF_S5BB + al256((size_t)SG * SP * SGC * 2 * 4);
constexpr size_t OFF_GT = OFF_SELM + al256((size_t)T * NG * 4);
constexpr size_t OFF_RINV = OFF_GT + al256((size_t)T * NH * 3 * 4);
constexpr int NPS = 32;
constexpr size_t OFF_SSQ = OFF_RINV + al256((size_t)T * 4);
constexpr size_t OFF_W_RIN = OFF_SSQ + al256((size_t)T * NPS * 4);
constexpr size_t OFF_W_ROUT = OFF_W_RIN + al256((size_t)RIN * D * 2);
constexpr size_t OFF_W_NIN = OFF_W_ROUT + al256((size_t)D * RVW * 2);
constexpr size_t OFF_W_CMP = OFF_W_NIN + al256((size_t)NSA_INP * D * 2);
constexpr size_t OFF_W_CMP2 = OFF_W_CMP + al256((size_t)2 * CHID * CK * 2);
constexpr size_t OFF_W_NOUT = OFF_W_CMP2 + al256((size_t)2 * NDH * CHID * 2);
constexpr size_t OFF_W_SIN = OFF_W_NOUT + al256((size_t)D * D * 2);
constexpr size_t OFF_W_SGLU = OFF_W_SIN + al256((size_t)D * D * 2);
constexpr size_t OFF_W_FGU = OFF_W_SGLU + al256((size_t)2 * D * D * 2);
constexpr size_t OFF_W_FDN = OFF_W_FGU + al256((size_t)2 * DFF * D * 2);
constexpr size_t OFF_W_MGU = OFF_W_FDN + al256((size_t)D * DFF * 2);
constexpr size_t OFF_W_MDN = OFF_W_MGU + al256((size_t)NE * 2 * DFE * D * 2);
constexpr size_t OFF_W_PPROJ = OFF_W_MDN + al256((size_t)NE * D * DFE * 2);
constexpr size_t OFF_W_PGATE = OFF_W_PPROJ + al256((size_t)D * PLE * 2);
constexpr size_t OFF_SCR = OFF_W_PGATE + al256((size_t)D * D * 2);
constexpr size_t SC_RET_RAW = 0, SC_RET_KT = al256((size_t)T * RIN * 2), SC_RET_VT = SC_RET_KT + al256((size_t)T * RH * RDK * 2), SC_RET_END = SC_RET_VT + al256((size_t)T * RVW * 2);
constexpr size_t SC_FFN_ACT = 0, SC_FFN_END = al256((size_t)T * DFF * 2);
constexpr size_t SC_MOE_ACT = 0, SC_MOE_Y = al256((size_t)MOE_ROWS * DFE * 2), SC_MOE_END = SC_MOE_Y + al256((size_t)MOE_ROWS * D * 2);
constexpr size_t SC_S5_U = 0, SC_S5_Y = al256((size_t)T * D * 2), SC_S5_END = 2 * al256((size_t)T * D * 2);
constexpr size_t KVB = al256((size_t)(NB * NG * S * NDH + CK) * 2);
constexpr size_t SC_N_RAW = 0, SC_N_QN = al256((size_t)T * NSA_INP * 2), SC_N_KS = SC_N_QN + al256((size_t)T * D * 2), SC_N_VS = SC_N_KS + KVB, SC_N_KW = SC_N_VS + KVB,
                 SC_N_VW = SC_N_KW + KVB, SC_N_KCR = SC_N_VW + KVB, SC_N_VCR = SC_N_KCR + KVB, SC_N_HID = SC_N_VCR + KVB, SC_N_KC = SC_N_HID + al256((size_t)2 * CMP_M * CHID * 2),
                 SC_N_VC = SC_N_KC + al256((size_t)CMP_M * NDH * 2), SC_N_OC = SC_N_VC + al256((size_t)CMP_M * NDH * 2), SC_N_OS = SC_N_OC + al256((size_t)T * D * 2),
                 SC_N_OW = SC_N_OS + al256((size_t)T * D * 2), SC_N_END = SC_N_OW + al256((size_t)T * D * 2);
constexpr size_t cmax(size_t a, size_t b) { return a > b ? a : b; }
constexpr size_t SCR_BYTES = cmax(cmax(SC_RET_END, SC_FFN_END), cmax(cmax(SC_MOE_END, SC_S5_END), SC_N_END));
constexpr size_t WS_NEED = OFF_SCR + SCR_BYTES;
constexpr int CW_BAR = 4096;
constexpr int CW_MOE = 8192;

enum { I_X = 0, I_P, I_POS, I_NMIX, I_NFFN, I_NPLE, I_RWIN, I_RGN, I_RWOUT, I_NWIN, I_NQN, I_NKN, I_NCPOS, I_NCW1, I_NCW2, I_NWOUT, I_SWIN, I_SARE, I_SAIM, I_SBRE, I_SBIM,
       I_SCRE, I_SCIM, I_SD, I_SLDT, I_SWGLU, I_FWGU, I_FWDN, I_MROUTER, I_MWGU, I_MWDN, I_PWPROJ, I_PWGATE, N_INPUTS };

struct Args { const float* in[N_INPUTS]; float* out; unsigned char* ws; int ph_lo, ph_hi; };

#ifdef HOST_SIM
struct Ctx { int bid, nblk; unsigned char* lds; int tid, lane, wave; unsigned char* ws; const Args* args; };
#define IN(i) (cx.args->in[i])
#define OUTP (cx.args->out)
#define FOR_THREADS(t) for (int t = 0; t < NT; ++t)
#define BLOCK_SYNC() ((void)0)
#define GRID_FOR(i, n) for (long i = cx.bid; i < (long)(n); i += cx.nblk)
#define ROW_FOR(r, n) for (long r = cx.bid; r < (long)(n); r += cx.nblk)
#define LANE_FOR(c, n) for (int c = 0; c < (n); ++c)
#define LANE_SLOTS(n) (n)
#define LANE_FOR_S(slot, c, n) for (int slot = 0, c = 0; c < (n); ++c, ++slot)
#define WAVE_SUM(x) (x)
#define WAVE_BCAST0(x) (x)
#define LANE0 true
#define ATOMIC_ADD(p, v) __atomic_fetch_add((p), (v), __ATOMIC_RELAXED)
#define LDS_ATOMIC_ADD(p, v) __atomic_fetch_add((p), (v), __ATOMIC_RELAXED)
#define LDSP(type, off) ((type*)(cx.lds + (off)))
#else
#define LAS __attribute__((address_space(3)))
struct Ctx { int bid, nblk; LAS unsigned char* lds; int tid, lane, wave; unsigned char* ws; };
constexpr int LDS_BYTES = 163840, LDS_MISC = 155648 + 320, LDS_TAB = 155648 + 1024;
__device__ __forceinline__ const float* in_ptr_(const Ctx& cx, int i) {
    const LAS unsigned* p = (const LAS unsigned*)(cx.lds + LDS_TAB) + 2 * i; const unsigned lo = __builtin_amdgcn_readfirstlane(p[0]), hi = __builtin_amdgcn_readfirstlane(p[1]);
    return (const float*)(__attribute__((address_space(1))) const float*)(((unsigned long long)hi << 32) | lo); }
#define IN(i) in_ptr_(cx, (i))
#define OUTP ((float*)in_ptr_(cx, N_INPUTS))
#define FOR_THREADS(t) for (int t = cx.tid, _once = 1; _once; _once = 0)
#define BLOCK_SYNC() __syncthreads()
#define GRID_FOR(i, n) for (long i = (long)cx.bid * NT + cx.tid; i < (long)(n); i += (long)cx.nblk * NT)
#define ROW_FOR(r, n) for (long r = (long)cx.bid * NWV + cx.wave; r < (long)(n); r += (long)cx.nblk * NWV)
#define LANE_FOR(c, n) for (int c = cx.lane; c < (n); c += 64)
#define LANE_SLOTS(n) ((n) / 64)
#define LANE_FOR_S(slot, c, n) _Pragma("unroll") for (int slot = 0, c = cx.lane; slot < LANE_SLOTS(n); ++slot, c += 64)
__device__ __forceinline__ float wave_sum_(float v) {
#pragma unroll
    for (int o = 1; o < 64; o <<= 1) v += __shfl_xor(v, o);
    return v;
}
#define WAVE_SUM(x) wave_sum_(x)
#define WAVE_BCAST0(x) __builtin_amdgcn_readfirstlane(x)
#define LANE0 (cx.lane == 0)
#define ATOMIC_ADD(p, v) atomicAdd((p), (v))
#define LDS_ATOMIC_ADD(p, v) __hip_atomic_fetch_add((p), (v), __ATOMIC_RELAXED, __HIP_MEMORY_SCOPE_WORKGROUP)
#define LDSP(type, off) ((LAS type*)(cx.lds + (off)))
#endif

#ifdef HOST_SIM
#define UNI_I(x) (x)
template <class P> inline P* uni_ptr(P* p) { return p; }
#else
#define UNI_I(x) __builtin_amdgcn_readfirstlane(x)
template <class P> __device__ __forceinline__ P* uni_ptr(P* p) { const unsigned long long v = (unsigned long long)p; const unsigned lo = __builtin_amdgcn_readfirstlane((unsigned)v), hi = __builtin_amdgcn_readfirstlane((unsigned)(v >> 32));
    return (P*)(__attribute__((address_space(1))) P*)(((unsigned long long)hi << 32) | lo); }
#endif
struct GUnit { const bf16* A; const bf16* B; const int* rows; int pm, pn, aux; };
constexpr int NXCD = 8, WGM = 8;
struct SchedDense {
    static constexpr bool GATHER = false;
    const bf16* A; const bf16* B; int lda, ldb, nM, nN, G, c;
    HD bool next(int i, GUnit& u) const {
        const long L = (long)i * G + c; const int nwg = nM * nN; if (c < 0 || L >= nwg) return false;
        int wgid = (int)L; { const int q = nwg / NXCD, r = nwg % NXCD, xcd = wgid % NXCD, off = wgid / NXCD; wgid = (xcd < r ? xcd * (q + 1) : r * (q + 1) + (xcd - r) * q) + off; }
        const int nig = WGM * nN, gid = wgid / nig, fm = gid * WGM, gsz = (nM - fm) < WGM ? (nM - fm) : WGM;
        u.pm = fm + ((wgid % nig) % gsz); u.pn = (wgid % nig) / gsz; u.aux = 0; u.rows = nullptr;
        u.A = uni_ptr(A + (size_t)u.pm * BMR * lda); u.B = uni_ptr(B + (size_t)u.pn * BN * ldb); return true;
    }
};
struct SchedCmp {
    static constexpr bool GATHER = false;
    const bf16* A0; const bf16* A1; const bf16* W; int G, c;
    HD bool next(int i, GUnit& u) const {
        const int L = i * G + c, nm = CMP_M / BMR; if (L >= 2 * nm) return false;
        const int kv = L / nm, pm = L % nm; u.pm = pm; u.pn = 0; u.aux = kv; u.rows = nullptr;
        u.A = uni_ptr((kv ? A1 : A0) + (size_t)pm * BMR * CLDA); u.B = uni_ptr(W + (size_t)kv * CHID * CK); return true;
    }
};
template <bool GATH> struct SchedMoE {
    static constexpr bool GATHER = GATH;
    const bf16* A; const bf16* W; const int* rows; int lda, wstride  , ldb, nN, G, c; int tl[NE + 1];
    HD void init(const int* cnt) { tl[0] = 0;
#pragma unroll
        for (int e = 0; e < NE; ++e) tl[e + 1] = tl[e] + (UNI_I(cnt[e]) + BMR - 1) / BMR; }
    HD bool next(int i, GUnit& u) const {
        const long L = (long)i * G + c; const int nM = tl[NE], nwg = nM * nN; if (L >= nwg) return false;
        int wgid = (int)L; { const int q = nwg / NXCD, r = nwg % NXCD, xcd = wgid % NXCD, off = wgid / NXCD; wgid = (xcd < r ? xcd * (q + 1) : r * (q + 1) + (xcd - r) * q) + off; }
        const int nig = WGM * nN, gid = wgid / nig, fm = gid * WGM, gsz = (nM - fm) < WGM ? (nM - fm) : WGM;
        const int rt = fm + ((wgid % nig) % gsz), pn = (wgid % nig) / gsz; int e = 0;
#pragma unroll
        for (int k = 1; k < NE; ++k) if (rt >= tl[k]) e = k;
        u.pm = rt; u.pn = pn; u.aux = e; u.B = uni_ptr(W + (size_t)e * wstride + (size_t)pn * BN * ldb);
        if (GATH) { u.rows = uni_ptr(rows + (size_t)rt * BMR); u.A = uni_ptr(A); } else { u.rows = nullptr; u.A = uni_ptr(A + (size_t)rt * BMR * lda); }
        return true;
    }
};
template <class E, class = void> struct has_rsc { static constexpr bool v = false; };
template <class E> struct has_rsc<E, decltype((void)E::RSC)> { static constexpr bool v = true; };
template <class E, class = void> struct has_hpre { static constexpr bool v = false; };
template <class E> struct has_hpre<E, decltype((void)E::HB)> { static constexpr bool v = true; };
template <class E, class = void> struct has_ssq { static constexpr bool v = false; };
template <class E> struct has_ssq<E, decltype((void)E::SSQ)> { static constexpr bool v = true; };
struct EStoreBf16 { static constexpr bool GATED = false, PERM = true; bf16* O; int ldo;
    HD void vec8(const GUnit& u, int r, int c0, const float* v) const { U4 w; w.x = pk2(v[0], v[1]); w.y = pk2(v[2], v[3]); w.z = pk2(v[4], v[5]); w.w = pk2(v[6], v[7]);
        *(U4*)(O + (size_t)(u.pm * BMR + r) * ldo + u.pn * BN + c0) = w; } };
struct EStoreBf16R { static constexpr bool GATED = false, PERM = true, RSC = true; bf16* O; int ldo; const float* rs;
    HD void vec8(const GUnit& u, int r, int c0, const float* v) const { EStoreBf16{O, ldo}.vec8(u, r, c0, v); } };
struct ERetIn { static constexpr bool GATED = true, PERM = true, RSC = true; bf16* RAW; bf16* KT; bf16* VT; const int* pos; const float* rs;
    static constexpr bool ROWPRE = true;
    HD float rowpre(const GUnit& u, int r) const { return u.pn < 2 * RH ? (float)pos[(size_t)u.pm * BMR + r] : 0.f; }
    HD void vec8g(const GUnit& u, int r, int j0, const float* a, const float* b2) const { vec8gp(u, r, j0, a, b2, rowpre(u, r)); }
    HD void vec8gp(const GUnit& u, int r, int j0, const float* a, const float* b2, float pp) const {
        const size_t row = (size_t)u.pm * BMR + r; const int pn = u.pn; bf16* rp = RAW + row * RIN + pn * BN + j0; const size_t bb = row / S, sx = row % S;
        if (pn < 2 * RH) { const int which = pn / RH, h = pn % RH;
            const float sc = which ? fexp2_((float)(RC - 1 - (int)(row % RC)) * log2_gamma_(h)) * (1.0f / sqrtf((float)RDK)) : 1.0f;
            float o1[8], o2[8];
#pragma unroll
            for (int e = 0; e < 8; ++e) { float cs, sn; rope_cs_(pp, 2 * (j0 + e), RDK, cs, sn); o1[e] = (a[e] * cs - b2[e] * sn) * sc; o2[e] = (b2[e] * cs + a[e] * sn) * sc; }
            U4 w1, w2; w1.x = pk2(o1[0], o1[1]); w1.y = pk2(o1[2], o1[3]); w1.z = pk2(o1[4], o1[5]); w1.w = pk2(o1[6], o1[7]); w2.x = pk2(o2[0], o2[1]); w2.y = pk2(o2[2], o2[3]); w2.z = pk2(o2[4], o2[5]); w2.w = pk2(o2[6], o2[7]);
            *(U4*)rp = w1; *(U4*)(rp + IB) = w2;
        } else { U4 w1, w2; w1.x = pk2(a[0], a[1]); w1.y = pk2(a[2], a[3]); w1.z = pk2(a[4], a[5]); w1.w = pk2(a[6], a[7]); w2.x = pk2(b2[0], b2[1]); w2.y = pk2(b2[2], b2[3]); w2.z = pk2(b2[4], b2[5]); w2.w = pk2(b2[6], b2[7]);
            *(U4*)rp = w1; *(U4*)(rp + IB) = w2; }
    } };
HD void ld8h(const bf16* p, float* h) { const U4 w = *(const U4*)p; h[0] = bf2f((bf16)(w.x & 0xffffu)); h[1] = bf2f((bf16)(w.x >> 16)); h[2] = bf2f((bf16)(w.y & 0xffffu)); h[3] = bf2f((bf16)(w.y >> 16));
    h[4] = bf2f((bf16)(w.z & 0xffffu)); h[5] = bf2f((bf16)(w.z >> 16)); h[6] = bf2f((bf16)(w.w & 0xffffu)); h[7] = bf2f((bf16)(w.w >> 16)); }
HD void up8h(const U4& w, float* h) { h[0] = bf2f((bf16)(w.x & 0xffffu)); h[1] = bf2f((bf16)(w.x >> 16)); h[2] = bf2f((bf16)(w.y & 0xffffu)); h[3] = bf2f((bf16)(w.y >> 16));
    h[4] = bf2f((bf16)(w.z & 0xffffu)); h[5] = bf2f((bf16)(w.z >> 16)); h[6] = bf2f((bf16)(w.w & 0xffffu)); h[7] = bf2f((bf16)(w.w >> 16)); }
HD void st8h(bf16* p, const float* h) { U4 w; w.x = pk2(h[0], h[1]); w.y = pk2(h[2], h[3]); w.z = pk2(h[4], h[5]); w.w = pk2(h[6], h[7]); *(U4*)p = w; }
struct EResAdd { static constexpr bool GATED = false, PERM = true, SSQ = true; static constexpr int HB = 4; bf16* Hm; float sg; float* ssq;
    struct Pre { U4 a, b; };
    HD float upd(bf16* p, const U4& raw, const float* v) const { float h[8], q = 0.f; up8h(raw, h);
#pragma unroll
        for (int i = 0; i < 8; ++i) { h[i] += sg * v[i]; q += h[i] * h[i]; }
        st8h(p, h); return q; }
    HD float vec8(const GUnit& u, int r, int c0, const float* v) const { bf16* p = Hm + (size_t)(u.pm * BMR + r) * D + u.pn * BN + c0; return upd(p, *(const U4*)p, v); }
    HD Pre hload(const GUnit& u, int r, int c0) const { const bf16* p = Hm + (size_t)(u.pm * BMR + r) * D + u.pn * BN + c0; Pre x; x.a = *(const U4*)p; x.b = *(const U4*)(p + BN / 2); return x; }
    HD float vec8p(const GUnit& u, int r, int c0, const float* v0, const float* v1, const Pre& x) const { bf16* p = Hm + (size_t)(u.pm * BMR + r) * D + u.pn * BN + c0; return upd(p, x.a, v0) + upd(p + BN / 2, x.b, v1); } };
struct ESwiGLU { static constexpr bool GATED = true, PERM = true, RSC = true; bf16* ACT; int ld; const float* rs;
    HD void vec8g(const GUnit& u, int r, int j0, const float* g, const float* up) const { float o[8];
#pragma unroll
        for (int i = 0; i < 8; ++i) o[i] = siluf_(g[i]) * up[i];
        U4 w; w.x = pk2(o[0], o[1]); w.y = pk2(o[2], o[3]); w.z = pk2(o[4], o[5]); w.w = pk2(o[6], o[7]);
        *(U4*)(ACT + (size_t)(u.pm * BMR + r) * ld + u.pn * IB + j0) = w; } };
struct ESwiGLU8R { static constexpr bool GATED = true, PERM = true, RSC = true; fp8* ACT; int ld; const float* rs;
    HD void vec8g(const GUnit& u, int r, int j0, const float* g, const float* up) const { float o[8];
#pragma unroll
        for (int i = 0; i < 8; ++i) o[i] = siluf_(g[i]) * up[i] * F8S_ACT;
        U2 w; w.x = pk4_f8(o[0], o[1], o[2], o[3]); w.y = pk4_f8(o[4], o[5], o[6], o[7]); *(U2*)(ACT + (size_t)(u.pm * BMR + r) * ld + u.pn * IB + j0) = w; } };
struct ESwiGLU8 { static constexpr bool GATED = true, PERM = true; fp8* ACT; int ld; float inv;
    HD void vec8g(const GUnit& u, int r, int j0, const float* g, const float* up) const { float o[8];
#pragma unroll
        for (int i = 0; i < 8; ++i) o[i] = siluf_(g[i] * inv) * (up[i] * inv) * F8S_ACT;
        U2 w; w.x = pk4_f8(o[0], o[1], o[2], o[3]); w.y = pk4_f8(o[4], o[5], o[6], o[7]); *(U2*)(ACT + (size_t)(u.pm * BMR + r) * ld + u.pn * IB + j0) = w; } };
struct EStoreBf16S { static constexpr bool GATED = false, PERM = true; bf16* O; int ldo; float sc;
    HD void vec8(const GUnit& u, int r, int c0, const float* v) const { U4 w; w.x = pk2(v[0] * sc, v[1] * sc); w.y = pk2(v[2] * sc, v[3] * sc); w.z = pk2(v[4] * sc, v[5] * sc); w.w = pk2(v[6] * sc, v[7] * sc);
        *(U4*)(O + (size_t)(u.pm * BMR + r) * ldo + u.pn * BN + c0) = w; } };
struct EGlu { static constexpr bool GATED = true, PERM = true, SSQ = true; static constexpr int HB = 4; bf16* Hm; float sg; float* ssq;
    struct Pre { U4 a; };
    HD float upd(bf16* p, const U4& raw, const float* a, const float* b) const { float h[8], q = 0.f; up8h(raw, h);
#pragma unroll
        for (int i = 0; i < 8; ++i) { h[i] += sg * a[i] * sigmoidf_(b[i]); q += h[i] * h[i]; }
        st8h(p, h); return q; }
    HD float vec8g(const GUnit& u, int r, int j0, const float* a, const float* b) const { bf16* p = Hm + (size_t)(u.pm * BMR + r) * D + u.pn * IB + j0; return upd(p, *(const U4*)p, a, b); }
    HD Pre hload(const GUnit& u, int r, int j0) const { Pre x; x.a = *(const U4*)(Hm + (size_t)(u.pm * BMR + r) * D + u.pn * IB + j0); return x; }
    HD float vec8p(const GUnit& u, int r, int j0, const float* a, const float* b, const Pre& x) const { return upd(Hm + (size_t)(u.pm * BMR + r) * D + u.pn * IB + j0, x.a, a, b); } };
struct EPle { static constexpr bool GATED = false, PERM = true, RSC = true, SSQ = true; static constexpr int HB = 2; const bf16* Hin; bf16* Hb; float* Hf; const bf16* PROJ; float sg; const float* rs; float* ssq;
    struct Pre { U4 h0, h1, p0, p1; };
    HD float upd(size_t i, const U4& hraw, const U4& praw, const float* v) const { float h[8], pj[8], q = 0.f; up8h(hraw, h); up8h(praw, pj);
#pragma unroll
        for (int e = 0; e < 8; ++e) { h[e] += sg * sigmoidf_(v[e]) * pj[e]; q += h[e] * h[e]; }
        if (Hf) { F4 o0, o1; o0.x = h[0]; o0.y = h[1]; o0.z = h[2]; o0.w = h[3]; o1.x = h[4]; o1.y = h[5]; o1.z = h[6]; o1.w = h[7]; *(F4*)(Hf + i) = o0; *(F4*)(Hf + i + 4) = o1; }
        else st8h(Hb + i, h);
        return q; }
    HD float vec8(const GUnit& u, int r, int c0, const float* v) const { const size_t i = (size_t)(u.pm * BMR + r) * D + u.pn * BN + c0; return upd(i, *(const U4*)(Hin + i), *(const U4*)(PROJ + i), v); }
    HD Pre hload(const GUnit& u, int r, int c0) const { const size_t i = (size_t)(u.pm * BMR + r) * D + u.pn * BN + c0; Pre x; x.h0 = *(const U4*)(Hin + i); x.h1 = *(const U4*)(Hin + i + BN / 2); x.p0 = *(const U4*)(PROJ + i); x.p1 = *(const U4*)(PROJ + i + BN / 2); return x; }
    HD float vec8p(const GUnit& u, int r, int c0, const float* v0, const float* v1, const Pre& x) const { const size_t i = (size_t)(u.pm * BMR + r) * D + u.pn * BN + c0; return upd(i, x.h0, x.p0, v0) + upd(i + BN / 2, x.h1, x.p1, v1); } };
struct ECmp { static constexpr bool GATED = false, PERM = true; bf16* HID; const float* bias;
    HD void vec8(const GUnit& u, int r, int c0, const float* v) const { float o[8];
#pragma unroll
        for (int i = 0; i < 8; ++i) o[i] = geluf_(v[i] + bias[u.aux * CHID + c0 + i]);
        U4 w; w.x = pk2(o[0], o[1]); w.y = pk2(o[2], o[3]); w.z = pk2(o[4], o[5]); w.w = pk2(o[6], o[7]);
        *(U4*)(HID + ((size_t)u.aux * CMP_M + u.pm * BMR + r) * CHID + c0) = w; } };

#ifdef HOST_SIM
template <bool F8 = false, class Epi, class Sched> inline void gemm_run(const Ctx& cx, int lda, int ldb, int K, const Sched& Sc, const Epi& E) {
    GUnit u;
    for (int i = 0; Sc.next(i, u); ++i)
        for (int r = 0; r < BMR; ++r) {
            float accs[BN];
            if constexpr (F8) { const fp8* a = (const fp8*)u.A + (size_t)r * lda;
                for (int c = 0; c < BN; ++c) { const fp8* b = (const fp8*)u.B + (size_t)c * ldb; float s = 0.f; for (int k = 0; k < K; ++k) s += f82f(a[k]) * f82f(b[k]); accs[c] = s; } }
            else { const bf16* a = u.rows ? u.A + (size_t)u.rows[r] * lda : u.A + (size_t)r * lda;
                for (int c = 0; c < BN; ++c) { const bf16* b = u.B + (size_t)c * ldb; float s = 0.f; for (int k = 0; k < K; ++k) s += bf2f(a[k]) * bf2f(b[k]); accs[c] = s; } }
            if constexpr (has_rsc<Epi>::v) { const float rsc = E.rs[(size_t)u.pm * BMR + r]; for (int c = 0; c < BN; ++c) accs[c] *= rsc; }
            if constexpr (has_ssq<Epi>::v) { float q = 0.f;
                if constexpr (Epi::GATED) { for (int j = 0; j < IB; j += 8) q += E.vec8g(u, r, j, accs + j, accs + IB + j); } else { for (int c = 0; c < BN; c += 8) q += E.vec8(u, r, c, accs + c); }
                float* sp = E.ssq + ((size_t)u.pm * BMR + r) * NPS + u.pn * 4; sp[0] = q; sp[1] = sp[2] = sp[3] = 0.f; }
            else if constexpr (Epi::GATED && Epi::PERM) { for (int j = 0; j < IB; j += 8) E.vec8g(u, r, j, accs + j, accs + IB + j); }
            else if constexpr (Epi::GATED) { for (int j = 0; j < IB; j += 4) E.vec4g(u, r, j, accs + j, accs + IB + j); }
            else if constexpr (Epi::PERM) { for (int c = 0; c < BN; c += 8) E.vec8(u, r, c, accs + c); }
            else { for (int c = 0; c < BN; c += 4) E.vec4(u, r, c, accs + c); }
        }
}
#else
namespace pg8 {
typedef short bf16x8 __attribute__((ext_vector_type(8)));
typedef float f32x4 __attribute__((ext_vector_type(4)));
constexpr int BK = 64, HALF = 128, HTB = HALF * BK * 2, STAGE_BYTES = 8 * HTB;
__device__ __forceinline__ int lds_byte(int r, int c) { const int st = (r >> 4) * 2 + (c >> 5), rr = r & 15, cc = c & 31, ob = rr * 64 + cc * 2; return st * 1024 + (ob ^ (((ob >> 9) & 1) << 5)); }
__device__ __forceinline__ void stage_rc(int b, int& R, int& C) { const int st = b / 1024, sb = b % 1024, swz = sb ^ (((sb >> 9) & 1) << 5); R = (st >> 1) * 16 + swz / 64; C = (st & 1) * 32 + (swz % 64) / 2; }

__device__ __forceinline__ int perm32(int rho) { const int n = rho >> 4, i = rho & 15; return 8 * (i >> 2) + 4 * n + (i & 3); }
template <class E, class = void> struct has_rowpre { static constexpr bool v = false; };
template <class E> struct has_rowpre<E, decltype((void)E::ROWPRE)> { static constexpr bool v = true; };
template <class E> struct EpiWrap {
    static constexpr bool PERM = E::PERM;
    E e;
    __device__ __forceinline__ void operator()(const f32x4 (&acc)[2][2][4][2], const GUnit& u, int wr, int wc, int fr, int fq) const {
        int rbase = wr * 64 + fr; asm volatile("" : "+v"(rbase));
        float rsv[8];
        if constexpr (has_rsc<E>::v) {
#pragma unroll
            for (int q = 0; q < 8; ++q) rsv[q] = e.rs[(size_t)u.pm * BMR + (q >> 2) * HALF + (q & 3) * 16 + rbase]; }
        float pre[8];
        if constexpr (has_rowpre<E>::v) {
#pragma unroll
            for (int q = 0; q < 8; ++q) pre[q] = e.rowpre(u, (q >> 2) * HALF + (q & 3) * 16 + rbase); }
        if constexpr (has_hpre<E>::v) {
            constexpr int HB = E::HB; const int c0 = wc * 32 + 8 * fq;
#pragma unroll
            for (int ai = 0; ai < 2; ++ai)
#pragma unroll
                for (int mb = 0; mb < 4; mb += HB) { int r0 = ai * HALF + mb * 16 + rbase; asm volatile("" : "+v"(r0));
                    typename E::Pre px[HB];
#pragma unroll
                    for (int k = 0; k < HB; ++k) px[k] = e.hload(u, r0 + 16 * k, c0);
#pragma unroll
                    for (int k = 0; k < HB; ++k) { const int m = mb + k, r = r0 + 16 * k; float v0[8], v1[8];
#pragma unroll
                        for (int j = 0; j < 4; ++j) { v0[j] = acc[ai][0][m][0][j]; v0[4 + j] = acc[ai][0][m][1][j]; v1[j] = acc[ai][1][m][0][j]; v1[4 + j] = acc[ai][1][m][1][j]; }
                        if constexpr (has_rsc<E>::v) {
#pragma unroll
                            for (int j = 0; j < 8; ++j) { v0[j] *= rsv[ai * 4 + m]; v1[j] *= rsv[ai * 4 + m]; } }
                        float q = e.vec8p(u, r, c0, v0, v1, px[k]);
                        q += __shfl_xor(q, 16); q += __shfl_xor(q, 32);
                        if (fq == 0) e.ssq[((size_t)u.pm * BMR + r) * NPS + u.pn * 4 + wc] = q; }
                    asm volatile("" ::: "memory"); }
            return;
        }
#pragma unroll
        for (int ai = 0; ai < 2; ++ai)
#pragma unroll
            for (int m = 0; m < 4; ++m) { int r = ai * HALF + m * 16 + rbase; asm volatile("" : "+v"(r));
                if constexpr (E::PERM) { const int c0 = wc * 32 + 8 * fq;
                    float v0[8], v1[8];
#pragma unroll
                    for (int j = 0; j < 4; ++j) { v0[j] = acc[ai][0][m][0][j]; v0[4 + j] = acc[ai][0][m][1][j]; v1[j] = acc[ai][1][m][0][j]; v1[4 + j] = acc[ai][1][m][1][j]; }
                    if constexpr (has_rsc<E>::v) {
#pragma unroll
                        for (int j = 0; j < 8; ++j) { v0[j] *= rsv[ai * 4 + m]; v1[j] *= rsv[ai * 4 + m]; } }
                    if constexpr (has_ssq<E>::v) { float q; if constexpr (E::GATED) q = e.vec8g(u, r, c0, v0, v1); else q = e.vec8(u, r, c0, v0) + e.vec8(u, r, HALF + c0, v1);
                        q += __shfl_xor(q, 16); q += __shfl_xor(q, 32);
                        if (fq == 0) e.ssq[((size_t)u.pm * BMR + r) * NPS + u.pn * 4 + wc] = q; }
                    else if constexpr (has_rowpre<E>::v) e.vec8gp(u, r, c0, v0, v1, pre[ai * 4 + m]); else if constexpr (E::GATED) e.vec8g(u, r, c0, v0, v1); else { e.vec8(u, r, c0, v0); e.vec8(u, r, HALF + c0, v1); }
                } else {
#pragma unroll
                    for (int n = 0; n < 2; ++n) { const int c0 = wc * 32 + n * 16 + fq * 4;
                        float v0[4], v1[4];
#pragma unroll
                        for (int j = 0; j < 4; ++j) { v0[j] = acc[ai][0][m][n][j]; v1[j] = acc[ai][1][m][n][j]; }
                        static_assert(!has_rsc<E>::v, "row scale is implemented for PERM epilogues");
                        if constexpr (E::GATED) e.vec4g(u, r, c0, v0, v1); else { e.vec4(u, r, c0, v0); e.vec4(u, r, HALF + c0, v1); } }
                }
                asm volatile("" ::: "memory"); }
    }
};

template <class Epi, class Sched, bool SP2 = true, bool ALIGN_EPI = true, bool F8 = false>
__device__ __forceinline__ void gemm_phase(LAS unsigned char* lds, const int tid, const int lda_b, const int ldb_b, const int K, const Sched& S, const Epi& E) {
    const int wid = __builtin_amdgcn_readfirstlane(tid >> 6), lane = tid & 63, wr = wid >> 2, wc = wid & 3, fr = lane & 15, fq = lane >> 4;
    int nt = F8 ? K / (2 * BK) : K / BK; asm volatile("" : "+s"(nt));
    const int f8one_ = 0x7f;
    unsigned voffB[2];
#pragma unroll
    for (int i = 0; i < 2; ++i) { int R, C; stage_rc(tid * 16 + i * 8192, R, C); const int Rb = Epi::PERM ? ((R & ~31) + perm32(R & 31)) : R; voffB[i] = (unsigned)(Rb * ldb_b + C * 2); }
    const size_t kstep = (size_t)(BK * 2);
    const size_t hstepB = (size_t)HALF * ldb_b;
    const size_t hstepA = Sched::GATHER ? (size_t)0 : (size_t)HALF * lda_b;
    const unsigned ldsw = (unsigned)wid * 1024u;
    const int aoff = lds_byte(wr * 64 + fr, fq * 8), boff = lds_byte(wc * 32 + fr, fq * 8);
#define PG8_SA(b, h) (((b) * 2 + (h)) * HTB)
#define PG8_SB(b, h) ((4 + (b) * 2 + (h)) * HTB)
#define PG8_STAGE(bufoff, gbase, v0, v1) do { \
        __builtin_amdgcn_global_load_lds((const unsigned*)((const char*)(gbase) + (v0)), (LAS unsigned*)(lds + (bufoff) + ldsw), 16, 0, 0); \
        __builtin_amdgcn_global_load_lds((const unsigned*)((const char*)(gbase) + (v1)), (LAS unsigned*)(lds + (bufoff) + ldsw + 8192), 16, 0, 0); } while (0)
#define PG8_LDA(dst, b, h) do { _Pragma("unroll") for (int m = 0; m < 4; ++m) _Pragma("unroll") for (int k = 0; k < 2; ++k) dst[m][k] = *(const LAS bf16x8*)(lds + PG8_SA(b, h) + aoff + m * 2048 + k * 1024); } while (0)
#define PG8_LDB(dst, b, h) do { _Pragma("unroll") for (int n = 0; n < 2; ++n) _Pragma("unroll") for (int k = 0; k < 2; ++k) dst[n][k] = *(const LAS bf16x8*)(lds + PG8_SB(b, h) + boff + n * 2048 + k * 1024); } while (0)
#define PG8_MMA(ai, bj, At, Bt) do { __builtin_amdgcn_s_setprio(1); _Pragma("unroll") for (int m = 0; m < 4; ++m) _Pragma("unroll") for (int n = 0; n < 2; ++n) { \
        if constexpr (F8) { typedef int i32x4_ __attribute__((ext_vector_type(4))); typedef int i32x8_ __attribute__((ext_vector_type(8))); \
            const i32x8_ b8_ = __builtin_shufflevector((i32x4_)Bt[n][0], (i32x4_)Bt[n][1], 0, 1, 2, 3, 4, 5, 6, 7), a8_ = __builtin_shufflevector((i32x4_)At[m][0], (i32x4_)At[m][1], 0, 1, 2, 3, 4, 5, 6, 7); \
            asm volatile("v_mfma_scale_f32_16x16x128_f8f6f4 %0, %1, %2, %0, %3, %3 op_sel_hi:[0,0,0]" : "+v"(acc[ai][bj][m][n]) : "v"(b8_), "v"(a8_), "v"(f8one_)); } \
        else { _Pragma("unroll") for (int k = 0; k < 2; ++k) acc[ai][bj][m][n] = __builtin_amdgcn_mfma_f32_16x16x32_bf16(Bt[n][k], At[m][k], acc[ai][bj][m][n], 0, 0, 0); } } \
        __builtin_amdgcn_s_setprio(0); } while (0)
#define PG8_WAIT_V(n) asm volatile("s_waitcnt vmcnt(" #n ")" ::: "memory")
#define PG8_WAIT_L(n) asm volatile("s_waitcnt lgkmcnt(" #n ")" ::: "memory")
#define PG8_BAR __builtin_amdgcn_s_barrier()
#define PG8_SCHED __builtin_amdgcn_sched_barrier(0)
#define PG8_VOFFA(dst, un) do { _Pragma("unroll") for (int h = 0; h < 2; ++h) _Pragma("unroll") for (int i = 0; i < 2; ++i) { int R_, C_; stage_rc(tid * 16 + i * 8192, R_, C_); \
        int ri = R_; if constexpr (Sched::GATHER) ri = (un).rows[h * HALF + R_]; dst[h][i] = (unsigned)ri * (unsigned)lda_b + (unsigned)(C_ * 2); } } while (0)
    GUnit cur, nxt; int ui = 0;
    if (!S.next(0, cur)) return;
    f32x4 acc[2][2][4][2];
#pragma unroll
    for (int a = 0; a < 2; ++a)
#pragma unroll
        for (int b = 0; b < 2; ++b)
#pragma unroll
            for (int m = 0; m < 4; ++m)
#pragma unroll
                for (int n = 0; n < 2; ++n) acc[a][b][m][n] = (f32x4){0.f, 0.f, 0.f, 0.f};
    bf16x8 At[4][2], B0[2][2], B1[2][2];
    unsigned vA[2][2], nvA[2][2];
    PG8_VOFFA(vA, cur);
    const char* cA = (const char*)cur.A; const char* cB = (const char*)cur.B;
    if constexpr (SP2) {
        PG8_STAGE(PG8_SB(0, 0), cB, voffB[0], voffB[1]); PG8_STAGE(PG8_SB(0, 1), cB + hstepB, voffB[0], voffB[1]); PG8_STAGE(PG8_SA(0, 0), cA, vA[0][0], vA[0][1]); PG8_STAGE(PG8_SA(0, 1), cA + hstepA, vA[1][0], vA[1][1]);
        if (wr == 1) PG8_BAR;
        PG8_WAIT_V(2); PG8_BAR;
        PG8_STAGE(PG8_SB(1, 0), cB + kstep, voffB[0], voffB[1]); PG8_STAGE(PG8_SA(1, 0), cA + kstep, vA[0][0], vA[0][1]); PG8_STAGE(PG8_SB(1, 1), cB + hstepB + kstep, voffB[0], voffB[1]);
        PG8_WAIT_V(6); PG8_BAR;
    } else {
    PG8_STAGE(PG8_SB(0, 0), cB, voffB[0], voffB[1]); PG8_STAGE(PG8_SA(0, 0), cA, vA[0][0], vA[0][1]); PG8_STAGE(PG8_SB(0, 1), cB + hstepB, voffB[0], voffB[1]); PG8_STAGE(PG8_SA(0, 1), cA + hstepA, vA[1][0], vA[1][1]);
    if (wr == 1) PG8_BAR;
    PG8_WAIT_V(4); PG8_BAR;
    PG8_STAGE(PG8_SB(1, 0), cB + kstep, voffB[0], voffB[1]); PG8_STAGE(PG8_SA(1, 0), cA + kstep, vA[0][0], vA[0][1]); PG8_STAGE(PG8_SB(1, 1), cB + hstepB + kstep, voffB[0], voffB[1]);
    PG8_WAIT_V(6); PG8_BAR;
    }
    for (;;) {
        const bool has_next = S.next(ui + 1, nxt);
        if (!has_next) nxt = cur;
        if constexpr (Sched::GATHER) { PG8_VOFFA(nvA, nxt); }
        const char* nA = (const char*)nxt.A; const char* nB = (const char*)nxt.B;
#pragma nounroll
        for (int t = 0; t < nt; t += 2) {
            const bool last = (t == nt - 2);
            const char* a1 = cA + (size_t)(t + 1) * kstep;
            const char* a2 = last ? nA : cA + (size_t)(t + 2) * kstep; const char* b2 = last ? nB : cB + (size_t)(t + 2) * kstep;
            const char* a3 = a2 + kstep; const char* b3 = b2 + kstep;
            unsigned w00 = vA[0][0], w01 = vA[0][1], w10 = vA[1][0], w11 = vA[1][1];
            if constexpr (Sched::GATHER) { if (last) { w00 = nvA[0][0]; w01 = nvA[0][1]; w10 = nvA[1][0]; w11 = nvA[1][1]; } }
            if constexpr (SP2) {
            PG8_LDB(B0, 0, 0); PG8_LDB(B1, 0, 1); PG8_SCHED; PG8_LDA(At, 0, 0); PG8_STAGE(PG8_SA(1, 1), a1 + hstepA, vA[1][0], vA[1][1]);
            PG8_WAIT_V(8); PG8_WAIT_L(0); PG8_BAR; PG8_MMA(0, 0, At, B0); PG8_MMA(0, 1, At, B1); PG8_BAR; PG8_SCHED;
            PG8_LDA(At, 0, 1); PG8_STAGE(PG8_SB(0, 0), b2, voffB[0], voffB[1]); PG8_STAGE(PG8_SB(0, 1), b2 + hstepB, voffB[0], voffB[1]); PG8_STAGE(PG8_SA(0, 0), a2, w00, w01);
            PG8_WAIT_V(8); PG8_WAIT_L(0); PG8_BAR; PG8_MMA(1, 0, At, B0); PG8_MMA(1, 1, At, B1); PG8_BAR; PG8_SCHED;
            PG8_LDB(B0, 1, 0); PG8_LDB(B1, 1, 1); PG8_SCHED; PG8_LDA(At, 1, 0); PG8_STAGE(PG8_SA(0, 1), a2 + hstepA, w10, w11);
            PG8_WAIT_V(8); PG8_WAIT_L(0); PG8_BAR; PG8_MMA(0, 0, At, B0); PG8_MMA(0, 1, At, B1); PG8_BAR; PG8_SCHED;
            PG8_LDA(At, 1, 1); PG8_STAGE(PG8_SB(1, 0), b3, voffB[0], voffB[1]); PG8_STAGE(PG8_SB(1, 1), b3 + hstepB, voffB[0], voffB[1]); PG8_STAGE(PG8_SA(1, 0), a3, w00, w01);
            PG8_WAIT_V(8); PG8_WAIT_L(0); PG8_BAR; PG8_MMA(1, 0, At, B0); PG8_MMA(1, 1, At, B1); PG8_BAR; PG8_SCHED;
            } else {
            PG8_LDB(B0, 0, 0); PG8_SCHED; PG8_LDA(At, 0, 0); PG8_STAGE(PG8_SA(1, 1), a1 + hstepA, vA[1][0], vA[1][1]);
            PG8_WAIT_L(8); PG8_BAR; PG8_WAIT_L(0); PG8_MMA(0, 0, At, B0); PG8_BAR; PG8_SCHED;
            PG8_LDB(B1, 0, 1); PG8_STAGE(PG8_SB(0, 0), b2, voffB[0], voffB[1]);
            PG8_BAR; PG8_WAIT_L(0); PG8_MMA(0, 1, At, B1); PG8_BAR;
            PG8_LDA(At, 0, 1); PG8_STAGE(PG8_SA(0, 0), a2, w00, w01);
            PG8_BAR; PG8_WAIT_L(0); PG8_MMA(1, 0, At, B0); PG8_BAR; PG8_SCHED;
            PG8_STAGE(PG8_SB(0, 1), b2 + hstepB, voffB[0], voffB[1]);
            PG8_WAIT_V(6); PG8_BAR; PG8_MMA(1, 1, At, B1); PG8_BAR;
            PG8_LDB(B0, 1, 0); PG8_SCHED; PG8_LDA(At, 1, 0); PG8_STAGE(PG8_SA(0, 1), a2 + hstepA, w10, w11);
            PG8_WAIT_L(8); PG8_BAR; PG8_WAIT_L(0); PG8_MMA(0, 0, At, B0); PG8_BAR; PG8_SCHED;
            PG8_LDB(B1, 1, 1); PG8_STAGE(PG8_SB(1, 0), b3, voffB[0], voffB[1]);
            PG8_BAR; PG8_WAIT_L(0); PG8_MMA(0, 1, At, B1); PG8_BAR;
            PG8_LDA(At, 1, 1); PG8_STAGE(PG8_SA(1, 0), a3, w00, w01);
            PG8_BAR; PG8_WAIT_L(0); PG8_MMA(1, 0, At, B0); PG8_BAR; PG8_SCHED;
            PG8_STAGE(PG8_SB(1, 1), b3 + hstepB, voffB[0], voffB[1]);
            PG8_WAIT_V(6); PG8_BAR; PG8_MMA(1, 1, At, B1); PG8_BAR;
            }
        }
        if constexpr (F8) { asm volatile("s_nop 7\n\ts_nop 7\n\ts_nop 7" ::: "memory"); }
        if constexpr (ALIGN_EPI) { if (wr == 0) PG8_BAR; }
        E(acc, cur, wr, wc, fr, fq);
        if (!has_next) break;
#pragma unroll
        for (int a = 0; a < 2; ++a)
#pragma unroll
            for (int b = 0; b < 2; ++b)
#pragma unroll
                for (int m = 0; m < 4; ++m)
#pragma unroll
                    for (int n = 0; n < 2; ++n) acc[a][b][m][n] = (f32x4){0.f, 0.f, 0.f, 0.f};
        cur = nxt; cA = nA; cB = nB; ++ui;
        if constexpr (Sched::GATHER) {
#pragma unroll
            for (int h = 0; h < 2; ++h)
#pragma unroll
                for (int i = 0; i < 2; ++i) vA[h][i] = nvA[h][i]; }
        if constexpr (ALIGN_EPI) { if (wr == 1) PG8_BAR; }
    }
    PG8_WAIT_V(0);
    if constexpr (!ALIGN_EPI) { if (wr == 0) PG8_BAR; }
    PG8_BAR;
#undef PG8_SA
#undef PG8_SB
#undef PG8_STAGE
#undef PG8_LDA
#undef PG8_LDB
#undef PG8_MMA
#undef PG8_WAIT_V
#undef PG8_WAIT_L
#undef PG8_BAR
#undef PG8_SCHED
#undef PG8_VOFFA
}
}
template <bool F8 = false, class Epi, class Sched> __device__ __forceinline__ void gemm_run(const Ctx& cx, int lda, int ldb, int K, const Sched& Sc, const Epi& E) {
    pg8::EpiWrap<Epi> W{E};
    pg8::gemm_phase<pg8::EpiWrap<Epi>, Sched, true, true, F8>(cx.lds, cx.tid, F8 ? lda : lda * 2, F8 ? ldb : ldb * 2, K, Sc, W);
    __syncthreads();
}
#endif

HD int prep_col(int np, int Nsrc, int mode, int HW) {
    if (mode == 0) return np < Nsrc ? np : -1;
    const int t = np / (2 * IB), w = np % (2 * IB); return (w / IB) * HW + t * IB + (w % IB);
}
DEV void prep_transpose_multi(const Ctx& cx, const float* src, size_t src_ms, int nmat, int K, int Nsrc, bf16* dst, size_t dst_ms, int Np, int mode, int HW, float f8scale, const float* ksc = nullptr) {
    constexpr int NTI = 3, TS = PT_K * 64, NLD = (PT_K * 16 * NTI + NT - 1) / NT; static_assert(2 * NTI * TS * 4 <= 131072, "LDS budget of the phase scratch region");
    const int nkb = K / PT_K, nnb = Np / 64, npm = nkb * nnb, nit = npm * nmat;
    const int nset = (nit + cx.nblk * NTI - 1) / (cx.nblk * NTI);
    for (int st = 0; st <= nset; ++st) {
        const int itl = (st * cx.nblk + cx.bid) * NTI, its = ((st - 1) * cx.nblk + cx.bid) * NTI;
        const int bl = (st & 1) * NTI * TS, bs = ((st - 1) & 1) * NTI * TS;
        FOR_THREADS(t) {
            F4 v[NLD];
            for (int j = 0; j < NLD; ++j) { const int e = t + j * NT, q = e / (PT_K * 16), ee = e % (PT_K * 16), it = itl + q; v[j].x = v[j].y = v[j].z = v[j].w = 0.f;
                if (st < nset && q < NTI && it < nit) { const int mi = it / npm, ir = it % npm; const int k0 = (ir / nnb) * PT_K, n0 = (ir % nnb) * 64, kk = ee / 16, n4 = (ee % 16) * 4, col = prep_col(n0 + n4, Nsrc, mode, HW);
                    if (col >= 0) v[j] = *(const F4*)(src + (size_t)mi * src_ms + (size_t)(k0 + kk) * Nsrc + col); } }
            if (st > 0) { for (int q = 0; q < NTI; ++q) { const int it = its + q; if (it < nit) { const int mi = it / npm, ir = it % npm; const int k0 = (ir / nnb) * PT_K, n0 = (ir % nnb) * 64; unsigned char* dm = (unsigned char*)dst + (size_t)mi * dst_ms;
                for (int e = t; e < 64 * (PT_K / 8); e += NT) { const int nn = e / (PT_K / 8), k8 = (e % (PT_K / 8)) * 8; const int lb = bs + q * TS; float x[8];
#pragma unroll
                    for (int i = 0; i < 8; ++i) x[i] = LDSP(float, 0)[lb + (k8 + i) * 64 + (nn ^ k8)];
                    if (f8scale != 0.f) { U2 w8; w8.x = pk4_f8(x[0] * f8scale, x[1] * f8scale, x[2] * f8scale, x[3] * f8scale); w8.y = pk4_f8(x[4] * f8scale, x[5] * f8scale, x[6] * f8scale, x[7] * f8scale);
                        *(U2*)(dm + (size_t)(n0 + nn) * K + k0 + k8) = w8; }
                    else { if (ksc) { const F4 g0 = *(const F4*)(ksc + k0 + k8), g1 = *(const F4*)(ksc + k0 + k8 + 4); x[0] *= g0.x; x[1] *= g0.y; x[2] *= g0.z; x[3] *= g0.w; x[4] *= g1.x; x[5] *= g1.y; x[6] *= g1.z; x[7] *= g1.w; }
                        U4 w; w.x = pk2(x[0], x[1]); w.y = pk2(x[2], x[3]); w.z = pk2(x[4], x[5]); w.w = pk2(x[6], x[7]); *(U4*)(dm + ((size_t)(n0 + nn) * K + k0 + k8) * 2) = w; } } } } }
            for (int j = 0; j < NLD; ++j) { const int e = t + j * NT, q = e / (PT_K * 16), ee = e % (PT_K * 16);
                if (st < nset && q < NTI) { const int kk = ee / 16, n4 = (ee % 16) * 4; float* l = (float*)&LDSP(float, 0)[bl + q * TS + kk * 64 + (n4 ^ (kk & ~7))]; l[0] = v[j].x; l[1] = v[j].y; l[2] = v[j].z; l[3] = v[j].w; } }
        }
        BLOCK_SYNC();
    }
}
DEV void prep_transpose(const Ctx& cx, const float* src, int K, int Nsrc, bf16* dst, int Np, int mode, int HW, float f8scale = 0.f, const float* ksc = nullptr) {
    prep_transpose_multi(cx, src, 0, 1, K, Nsrc, dst, 0, Np, mode, HW, f8scale, ksc);
}
DEV void stage_norm(const Ctx& cx, const float* Xin, const bf16* Hin, bf16* Hcopy, const float* gain, bf16* XNo,
                    const bf16* Ymoe, const int* SLOTi, const float* TOPWi,
                    const float* router, int* TOPIo, float* TOPWo, int* CNTo, float* RINVo = nullptr, fp8* XN8o = nullptr) {
    constexpr int NC = D / 4, NS = LANE_SLOTS(NC) > 0 ? LANE_SLOTS(NC) : 1, NRW = 2;
    static_assert((NC % 64 == 0 || NC < 64) && T % NRW == 0, "row chunking");
    if (router) { FOR_THREADS(t) { if (t < NE) LDSP(int, 0)[t] = 0; } BLOCK_SYNC(); }
    ROW_FOR(rp, T / NRW) {
        F4 hv[NRW][NS]; float ss[NRW];
#pragma unroll
        for (int k = 0; k < NRW; ++k) { const size_t r = (size_t)rp * NRW + k; ss[k] = 0.f;
            int s0 = 0, s1 = 0; float w0 = 0.f, w1 = 0.f;
            if (Ymoe) { s0 = SLOTi[r * 2]; s1 = SLOTi[r * 2 + 1]; w0 = TOPWi[r * 2]; w1 = TOPWi[r * 2 + 1]; }
            LANE_FOR_S(sl, c, NC) { F4 v;
                if (Xin) v = *(const F4*)(Xin + r * D + 4 * c);
                else { const U2 hw = *(const U2*)(Hin + r * D + 4 * c); v.x = bf2f((bf16)(hw.x & 0xffffu)); v.y = bf2f((bf16)(hw.x >> 16)); v.z = bf2f((bf16)(hw.y & 0xffffu)); v.w = bf2f((bf16)(hw.y >> 16)); }
                if (Ymoe) { const U2 a = *(const U2*)(Ymoe + (size_t)s0 * D + 4 * c), b2 = *(const U2*)(Ymoe + (size_t)s1 * D + 4 * c);
                    v.x += w0 * bf2f((bf16)(a.x & 0xffffu)) + w1 * bf2f((bf16)(b2.x & 0xffffu)); v.y += w0 * bf2f((bf16)(a.x >> 16)) + w1 * bf2f((bf16)(b2.x >> 16));
                    v.z += w0 * bf2f((bf16)(a.y & 0xffffu)) + w1 * bf2f((bf16)(b2.y & 0xffffu)); v.w += w0 * bf2f((bf16)(a.y >> 16)) + w1 * bf2f((bf16)(b2.y >> 16)); }
                hv[k][sl] = v; ss[k] += (v.x * v.x + v.y * v.y) + (v.z * v.z + v.w * v.w); } }
#pragma unroll
        for (int k = 0; k < NRW; ++k) { const size_t r = (size_t)rp * NRW + k;
            if (Hcopy) { LANE_FOR_S(sl, c, NC) { U2 hw; hw.x = pk2(hv[k][sl].x, hv[k][sl].y); hw.y = pk2(hv[k][sl].z, hv[k][sl].w); *(U2*)(Hcopy + r * D + 4 * c) = hw; } }
            ss[k] = WAVE_SUM(ss[k]); }
#pragma unroll
        for (int k = 0; k < NRW; ++k) { const size_t r = (size_t)rp * NRW + k;
            const float rinv = 1.0f / sqrtf(ss[k] * (1.0f / D) + NORM_EPS);
            if (RINVo) { if (LANE0) RINVo[r] = rinv; }
            if (!XNo && !router && !XN8o) continue;
            float lg[NE];
#pragma unroll
            for (int e = 0; e < NE; ++e) lg[e] = 0.f;
            LANE_FOR_S(sl, c, NC) { const F4 g4 = *(const F4*)(gain + 4 * c); const F4 v = hv[k][sl];
                const float x0 = v.x * rinv * g4.x, x1 = v.y * rinv * g4.y, x2 = v.z * rinv * g4.z, x3 = v.w * rinv * g4.w;
                if (XNo) { U2 o; o.x = pk2(x0, x1); o.y = pk2(x2, x3); *(U2*)(XNo + r * D + 4 * c) = o; }
                if (XN8o) *(unsigned*)(XN8o + r * D + 4 * c) = pk4_f8(x0 * F8S_X, x1 * F8S_X, x2 * F8S_X, x3 * F8S_X);
                if (router) { const float* rp2 = router + (size_t)(4 * c) * NE;
#pragma unroll
                    for (int e = 0; e < NE; ++e) lg[e] += x0 * rp2[e] + x1 * rp2[NE + e] + x2 * rp2[2 * NE + e] + x3 * rp2[3 * NE + e]; } }
            if (router) {
#pragma unroll
                for (int e = 0; e < NE; ++e) lg[e] = WAVE_SUM(lg[e]);
                int i0 = 0; float b0 = lg[0];
#pragma unroll
                for (int e = 1; e < NE; ++e) if (lg[e] > b0) { b0 = lg[e]; i0 = e; }
                int i1 = -1; float b1 = -INFINITY;
#pragma unroll
                for (int e = 0; e < NE; ++e) if (e != i0 && lg[e] > b1) { b1 = lg[e]; i1 = e; }
                const float wa = 1.0f / (1.0f + expf(b1 - b0));
                if (LANE0) { TOPIo[r * 2] = i0; TOPIo[r * 2 + 1] = i1; TOPWo[r * 2] = wa; TOPWo[r * 2 + 1] = 1.0f - wa; LDS_ATOMIC_ADD(&LDSP(int, 0)[i0], 1); LDS_ATOMIC_ADD(&LDSP(int, 0)[i1], 1); }
            } }
    }
    if (router) { BLOCK_SYNC(); FOR_THREADS(t) { if (t < NE) ATOMIC_ADD(&CNTo[t], LDSP(int, 0)[t]); } BLOCK_SYNC(); }
}
DEV void stage_rinv(const Ctx& cx, const float* SSQi, int np, float* RINVo) {
    GRID_FOR(r, T) { float q = 0.f; for (int i = 0; i < np; i += 4) { const F4 v = *(const F4*)(SSQi + (size_t)r * NPS + i); q += (v.x + v.y) + (v.z + v.w); }
        RINVo[r] = 1.0f / sqrtf(q * (1.0f / D) + NORM_EPS); }
}
DEV void stage_p2b(const Ctx& cx, const float* p, bf16* PBo) {
    constexpr size_t NI = (size_t)T * PLE / 8; constexpr int UB = 4;
#ifdef HOST_SIM
    GRID_FOR(i, NI) { const F4 a = *(const F4*)(p + 8 * i), b2 = *(const F4*)(p + 8 * i + 4); U4 w; w.x = pk2(a.x, a.y); w.y = pk2(a.z, a.w); w.z = pk2(b2.x, b2.y); w.w = pk2(b2.z, b2.w); *(U4*)(PBo + 8 * i) = w; }
#else
    const size_t stride = (size_t)cx.nblk * NT;
    for (size_t i0 = (size_t)cx.bid * NT + cx.tid; i0 < NI; i0 += stride * UB) { F4 a[UB], b2[UB];
#pragma unroll
        for (int q = 0; q < UB; ++q) { const size_t i = i0 + q * stride; if (i < NI) { a[q] = *(const F4*)(p + 8 * i); b2[q] = *(const F4*)(p + 8 * i + 4); } }
#pragma unroll
        for (int q = 0; q < UB; ++q) { const size_t i = i0 + q * stride; if (i < NI) { U4 w; w.x = pk2(a[q].x, a[q].y); w.y = pk2(a[q].z, a[q].w); w.z = pk2(b2[q].x, b2[q].y); w.w = pk2(b2[q].z, b2[q].w); *(U4*)(PBo + 8 * i) = w; } } }
#endif
}
#ifdef HOST_SIM
struct alignas(16) moe_v4 { unsigned a, b, c, d; };
#else
typedef unsigned moe_v4 __attribute__((ext_vector_type(4)));
#endif
DEV void stage_moe_assign(const Ctx& cx, const int* TOPI_, int* SLOT_, const fp8* XN8_, bf16* XNP, const int* CNT_, int* CNT2_) {
    const int ntok = T / cx.nblk;
    constexpr int L_CNT = 0, L_BASE = 64, L_RUN = 128, L_SLOT = 256;
    FOR_THREADS(t) { if (t < NE) { LDSP(int, L_CNT)[t] = 0; LDSP(int, L_RUN)[t] = 0; } }
    BLOCK_SYNC();
    FOR_THREADS(t) { for (int idx = t; idx < ntok * 2; idx += NT) { const int tok = cx.bid + (idx >> 1) * cx.nblk; LDS_ATOMIC_ADD(&LDSP(int, L_CNT)[TOPI_[tok * 2 + (idx & 1)]], 1); } }
    BLOCK_SYNC();
    FOR_THREADS(t) { if (t < NE) { int bs = 0;
#pragma unroll
        for (int k = 0; k < NE; ++k) if (k < t) bs += ((CNT_[k] + BMR - 1) / BMR) * BMR;
        LDSP(int, L_BASE)[t] = bs + ATOMIC_ADD(&CNT2_[t], LDSP(int, L_CNT)[t]); } }
    BLOCK_SYNC();
    FOR_THREADS(t) { for (int idx = t; idx < ntok * 2; idx += NT) { const int tok = cx.bid + (idx >> 1) * cx.nblk, e = TOPI_[tok * 2 + (idx & 1)];
        const int slot = LDSP(int, L_BASE)[e] + LDS_ATOMIC_ADD(&LDSP(int, L_RUN)[e], 1); SLOT_[tok * 2 + (idx & 1)] = slot; LDSP(int, L_SLOT)[idx] = slot; } }
    BLOCK_SYNC();
    FOR_THREADS(t) { const int nchunk = ntok * 2 * (D / 16);
#define MOE_LD(q_, V_, S_) { int idx = idx0 + (q_) * NT; if (idx >= nchunk) idx = nchunk - 1; const int rowi = idx / (D / 16), ch = idx % (D / 16); const int tok = cx.bid + (rowi >> 1) * cx.nblk; \
            V_ = *(const moe_v4*)(XN8_ + (size_t)tok * D + ch * 16); S_ = LDSP(int, L_SLOT)[rowi]; }
#define MOE_ST(q_, V_, S_) { const int idx = idx0 + (q_) * NT; if (idx < nchunk) { const int ch = idx % (D / 16); *(moe_v4*)((fp8*)XNP + (size_t)(S_) * D + ch * 16) = V_; } }
        for (int idx0 = t; idx0 < nchunk; idx0 += NT * 4) { moe_v4 v0, v1, v2, v3; int s0, s1, s2, s3;
            MOE_LD(0, v0, s0) MOE_LD(1, v1, s1) MOE_LD(2, v2, s2) MOE_LD(3, v3, s3)
            MOE_ST(0, v0, s0) MOE_ST(1, v1, s1) MOE_ST(2, v2, s2) MOE_ST(3, v3, s3) } }
#undef MOE_LD
#undef MOE_ST
    BLOCK_SYNC();
}
DEV void stage_transpose_cols(const Ctx& cx, const bf16* src, int ld, int col0, int ncols, bf16* dst) {
    const int cw = (ncols % 64 == 0) ? 64 : 32, nct = ncols / cw, nst = S / 64, nit = NB * nst * nct;
    for (int it = cx.bid; it < nit; it += cx.nblk) {
        const int ct = it % nct, st = (it / nct) % nst, b = it / (nct * nst);
        FOR_THREADS(t) { for (int e = t; e < 64 * (cw / 8); e += NT) { const int ss = e / (cw / 8), c8 = (e % (cw / 8)) * 8;
            const U4 v = *(const U4*)(src + ((size_t)b * S + st * 64 + ss) * ld + col0 + ct * cw + c8); const unsigned w[4] = {v.x, v.y, v.z, v.w};
            for (int i = 0; i < 4; ++i) { LDSP(bf16, 0)[(c8 + 2 * i) * 72 + ss] = (bf16)(w[i] & 0xffffu); LDSP(bf16, 0)[(c8 + 2 * i + 1) * 72 + ss] = (bf16)(w[i] >> 16); } } }
        BLOCK_SYNC();
        FOR_THREADS(t) { for (int e = t; e < cw * 8; e += NT) { const int cc = e / 8, s8 = (e % 8) * 8;
            const U4 v = *(const U4*)&LDSP(bf16, 0)[cc * 72 + s8];
            *(U4*)(dst + ((size_t)b * ncols + ct * cw + cc) * S + st * 64 + s8) = v; } }
        BLOCK_SYNC();
    }
}
DEV void stage_transpose_cols2(const Ctx& cx, const bf16* src, int ld, int col0a, int col0b, int ncols, bf16* dsta, bf16* dstb) {
    constexpr int UB = 4, TSZ = 64 * 72;
    const int cw = (ncols % 64 == 0) ? 64 : 32, nct = ncols / cw, nst = S / 64, nit1 = NB * nst * nct, nit = 2 * nit1;
    for (int it0 = cx.bid; it0 < nit; it0 += UB * cx.nblk) {
        FOR_THREADS(t) { for (int e = t; e < 64 * (cw / 8); e += NT) { const int ss = e / (cw / 8), c8 = (e % (cw / 8)) * 8; U4 v[UB];
#pragma unroll
            for (int u = 0; u < UB; ++u) { const int it = it0 + u * cx.nblk; if (it < nit) { const int r = it % nit1, ct = r % nct, st = (r / nct) % nst, b = r / (nct * nst);
                v[u] = *(const U4*)(src + ((size_t)b * S + st * 64 + ss) * ld + (it < nit1 ? col0a : col0b) + ct * cw + c8); } }
#pragma unroll
            for (int u = 0; u < UB; ++u) { const int it = it0 + u * cx.nblk; if (it < nit) { const unsigned w[4] = {v[u].x, v[u].y, v[u].z, v[u].w};
                for (int i = 0; i < 4; ++i) { LDSP(bf16, 0)[u * TSZ + (c8 + 2 * i) * 72 + ss] = (bf16)(w[i] & 0xffffu); LDSP(bf16, 0)[u * TSZ + (c8 + 2 * i + 1) * 72 + ss] = (bf16)(w[i] >> 16); } } } } }
        BLOCK_SYNC();
        FOR_THREADS(t) { for (int e = t; e < cw * 8; e += NT) { const int cc = e / 8, s8 = (e % 8) * 8;
#pragma unroll
            for (int u = 0; u < UB; ++u) { const int it = it0 + u * cx.nblk; if (it < nit) { const int r = it % nit1, ct = r % nct, st = (r / nct) % nst, b = r / (nct * nst);
                const U4 vv = *(const U4*)&LDSP(bf16, 0)[u * TSZ + cc * 72 + s8];
                *(U4*)((it < nit1 ? dsta : dstb) + ((size_t)b * ncols + ct * cw + cc) * S + st * 64 + s8) = vv; } } } }
        BLOCK_SYNC();
    }
}
constexpr int VSW = RDV < 64 ? RDV : 64;
DEV void stage_ret_core(const Ctx& cx, const bf16* RAW, const bf16* KT, const bf16* VT, bf16* O) {
    constexpr int NVS = RDV / VSW, NU = NB * RH * NVS, NCH = S / RC;
    constexpr int L_R = 0, L_S = RDK * VSW * 4, L_O = L_S + RC * RC * 4;
    for (int un = cx.bid; un < NU; un += cx.nblk) {
        const int vs = un % NVS, h = (un / NVS) % RH, b = un / (NVS * RH);
        const float lg2h = log2_gamma_(h), cd = fexp2_((float)RC * lg2h);
        FOR_THREADS(t) { for (int e = t; e < RDK * VSW; e += NT) LDSP(float, L_R)[e] = 0.f; }
        BLOCK_SYNC();
        for (int n = 0; n < NCH; ++n) {
            const size_t r0 = (size_t)b * S + (size_t)n * RC;
            const bf16* Qb = RAW + r0 * RIN + h * RDK; const bf16* Kb = RAW + r0 * RIN + RH * RDK + h * RDK;
            const bf16* KTb = KT + ((size_t)b * RH * RDK + h * RDK) * S + n * RC; const bf16* Vb = RAW + r0 * RIN + 2 * RH * RDK + h * RDV + vs * VSW;
            FOR_THREADS(t) { for (int e = t; e < RC * RC; e += NT) { const int i = e / RC, j = e % RC; float sc = 0.f;
                if (j <= i) { const bf16* qp = Qb + (size_t)i * RIN; const bf16* kp = Kb + (size_t)j * RIN; for (int d = 0; d < RDK; ++d) sc += bf2f(qp[d]) * bf2f(kp[d]); sc /= cd; }
                LDSP(float, L_S)[e] = sc; } }
            BLOCK_SYNC();
            FOR_THREADS(t) { for (int e = t; e < RC * VSW; e += NT) { const int i = e / VSW, v = e % VSW; float a = 0.f;
                for (int j = 0; j <= i; ++j) a += LDSP(float, L_S)[i * RC + j] * bf2f(Vb[(size_t)j * RIN + v]);
                const bf16* qp = Qb + (size_t)i * RIN; for (int d = 0; d < RDK; ++d) a += bf2f(qp[d]) * LDSP(float, L_R)[d * VSW + v];
                LDSP(float, L_O)[e] = a * fexp2_((float)(i + 1) * lg2h); } }
            BLOCK_SYNC();
            FOR_THREADS(t) { for (int e = t; e < RDK * VSW; e += NT) { const int d = e / VSW, v = e % VSW; float a = 0.f;
                for (int j = 0; j < RC; ++j) a += bf2f(Kb[(size_t)j * RIN + d]) * bf2f(Vb[(size_t)j * RIN + v]);
                LDSP(float, L_R)[e] = LDSP(float, L_R)[e] * cd + a; } }
            BLOCK_SYNC();
            FOR_THREADS(t) { for (int e = t; e < RC * VSW; e += NT) { const int i = e / VSW, v = e % VSW; O[(r0 + i) * RIN + h * RDV + vs * VSW + v] = f2bf(LDSP(float, L_O)[e]); } }
            BLOCK_SYNC();
        }
    }
}
DEV void stage_ret_norm(const Ctx& cx, const bf16* O, const bf16* RAW, const float* gn, bf16* ON) {
    constexpr int NC = RDV / 8, NS = LANE_SLOTS(NC) > 0 ? LANE_SLOTS(NC) : 1;
    ROW_FOR(r, T) {
        U4 oa[RH][NS], ga[RH][NS];
#pragma unroll
        for (int h = 0; h < RH; ++h) { const bf16* op = O + (size_t)r * RIN + h * RDV; const bf16* gp = RAW + (size_t)r * RIN + 2 * RH * RDK + RH * RDV + h * RDV;
            LANE_FOR_S(sl, c, NC) { oa[h][sl] = *(const U4*)(op + 8 * c); ga[h][sl] = *(const U4*)(gp + 8 * c); } }
#pragma unroll
        for (int h = 0; h < RH; ++h) { bf16* onp = ON + (size_t)r * RVW + h * RDV;
            float ov[NS * 8], gv[NS * 8]; float s1 = 0.f;
            LANE_FOR_S(sl, c, NC) { const unsigned aw[4] = {oa[h][sl].x, oa[h][sl].y, oa[h][sl].z, oa[h][sl].w}, gw[4] = {ga[h][sl].x, ga[h][sl].y, ga[h][sl].z, ga[h][sl].w};
#pragma unroll
                for (int i = 0; i < 4; ++i) { ov[sl * 8 + 2 * i] = bf2f((bf16)(aw[i] & 0xffffu)); ov[sl * 8 + 2 * i + 1] = bf2f((bf16)(aw[i] >> 16)); gv[sl * 8 + 2 * i] = bf2f((bf16)(gw[i] & 0xffffu)); gv[sl * 8 + 2 * i + 1] = bf2f((bf16)(gw[i] >> 16)); }
#pragma unroll
                for (int i = 0; i < 8; ++i) s1 += ov[sl * 8 + i]; }
            s1 = WAVE_SUM(s1); const float mu = s1 * (1.0f / RDV); float s2 = 0.f;
            LANE_FOR_S(sl, c, NC) {
#pragma unroll
                for (int i = 0; i < 8; ++i) { const float d = ov[sl * 8 + i] - mu; s2 += d * d; } }
            s2 = WAVE_SUM(s2); const float rstd = 1.0f / sqrtf(s2 * (1.0f / RDV) + NORM_EPS);
            LANE_FOR_S(sl, c, NC) { float o[8];
#pragma unroll
                for (int i = 0; i < 8; ++i) o[i] = (ov[sl * 8 + i] - mu) * rstd * gn[h * RDV + 8 * c + i] * siluf_(gv[sl * 8 + i]);
                U4 w; w.x = pk2(o[0], o[1]); w.y = pk2(o[2], o[3]); w.z = pk2(o[4], o[5]); w.w = pk2(o[6], o[7]); *(U4*)(onp + 8 * c) = w; } }
    }
}
DEV void stage_s5_prep(const Ctx& cx, const float* a_re, const float* a_im, const float* b_re, const float* b_im, const float* log_dt, float* AB, float* BB) {
    GRID_FOR(i, SG * SP) {
        const int g = (int)(i / SP); const float dt = expf(log_dt[g]), ar = a_re[i], ai = a_im[i];
        const float mag = expf(dt * ar), abr = mag * cosf(dt * ai), abi = mag * sinf(dt * ai), den = ar * ar + ai * ai, nr = abr - 1.0f, ni = abi;
        const float fre = (nr * ar + ni * ai) / den, fim = (ni * ar - nr * ai) / den;
        float pr = abr, pi = abi;
        for (int k = 1; k < S / (NT / SP); k <<= 1) { const float n1 = pr * pr - pi * pi, n2 = 2.f * pr * pi; pr = n1; pi = n2; }
        AB[i * 4] = abr; AB[i * 4 + 1] = abi; AB[i * 4 + 2] = pr; AB[i * 4 + 3] = pi;
        for (int c = 0; c < SGC; ++c) { const float br = b_re[i * SGC + c], bi = b_im[i * SGC + c]; BB[(i * SGC + c) * 2] = fre * br - fim * bi; BB[(i * SGC + c) * 2 + 1] = fre * bi + fim * br; }
    }
}
DEV void stage_s5_core(const Ctx& cx, const bf16* U, bf16* Y, const float* AB, const float* BB, const float* c_re, const float* c_im, const float* dskip) {
    constexpr int NSEG = NT / SP, SEGL = S / NSEG, MC = 8, XBS = SP * 2 + 2, CS = SP + 1;
    constexpr int L_U = 0, L_CR = L_U + S * SGC * 2, L_CI = L_CR + SGC * CS * 4, L_XEND = L_CI + SGC * CS * 4, L_XIN = L_XEND + NSEG * SP * 2 * 4, L_ST = L_XIN + NSEG * SP * 2 * 4, L_XB = L_ST + NSEG * SP * 2 * 4,
                  L_END = L_XB + NSEG * MC * XBS * 4;
    static_assert(SP == 64 && NSEG == 8 && SEGL % MC == 0 && (SEGL & (SEGL - 1)) == 0 && SGC == 16 && L_END <= 131072, "s5 geometry");
    for (int un = cx.bid; un < NB * SG; un += cx.nblk) {
        const int g = un % SG, b = un / SG;
        FOR_THREADS(t) {
            for (int e = t; e < S * 2; e += NT) { const int sx = e >> 1, hf = e & 1; *(U4*)&LDSP(bf16, L_U)[sx * SGC + hf * 8] = *(const U4*)(U + ((size_t)b * S + sx) * D + g * SGC + hf * 8); }
            for (int e = t; e < SGC * SP; e += NT) { const int c = e / SP, p = e % SP; LDSP(float, L_CR)[c * CS + p] = c_re[((size_t)g * SGC + c) * SP + p]; LDSP(float, L_CI)[c * CS + p] = c_im[((size_t)g * SGC + c) * SP + p]; } }
        BLOCK_SYNC();
        FOR_THREADS(t) { const int w = t / SP, p = t % SP; const float abr = AB[(g * SP + p) * 4], abi = AB[(g * SP + p) * 4 + 1];
            float br[SGC], bi[SGC];
_Pragma("unroll") for (int c = 0; c < SGC; ++c) { br[c] = BB[((g * SP + p) * SGC + c) * 2]; bi[c] = BB[((g * SP + p) * SGC + c) * 2 + 1]; }
            float xr = 0.f, xi = 0.f;
            for (int sx = w * SEGL; sx < (w + 1) * SEGL; ++sx) { const U4 u0 = *(const U4*)&LDSP(bf16, L_U)[sx * SGC], u1 = *(const U4*)&LDSP(bf16, L_U)[sx * SGC + 8]; const unsigned uw[8] = {u0.x, u0.y, u0.z, u0.w, u1.x, u1.y, u1.z, u1.w};
                float ur = 0.f, ui = 0.f;
_Pragma("unroll") for (int c = 0; c < SGC; ++c) { const float uv = bf2f((bf16)((c & 1) ? (uw[c >> 1] >> 16) : (uw[c >> 1] & 0xffffu))); ur += br[c] * uv; ui += bi[c] * uv; }
                const float nr = abr * xr - abi * xi + ur, ni = abr * xi + abi * xr + ui; xr = nr; xi = ni; }
            LDSP(float, L_XEND)[(w * SP + p) * 2] = xr; LDSP(float, L_XEND)[(w * SP + p) * 2 + 1] = xi; }
        BLOCK_SYNC();
        FOR_THREADS(t) { if (t < SP) { const int p = t; const float pr = AB[(g * SP + p) * 4 + 2], pi = AB[(g * SP + p) * 4 + 3];
            float xr = 0.f, xi = 0.f;
            for (int w = 0; w < NSEG; ++w) { LDSP(float, L_XIN)[(w * SP + p) * 2] = xr; LDSP(float, L_XIN)[(w * SP + p) * 2 + 1] = xi;
                const float er = LDSP(float, L_XEND)[(w * SP + p) * 2], ei = LDSP(float, L_XEND)[(w * SP + p) * 2 + 1];
                const float nr = pr * xr - pi * xi + er, ni = pr * xi + pi * xr + ei; xr = nr; xi = ni; } } }
        BLOCK_SYNC();
        for (int mc = 0; mc < SEGL / MC; ++mc) {
            FOR_THREADS(t) { const int w = t / SP, p = t % SP; const float abr = AB[(g * SP + p) * 4], abi = AB[(g * SP + p) * 4 + 1];
                float br[SGC], bi[SGC];
_Pragma("unroll") for (int c = 0; c < SGC; ++c) { br[c] = BB[((g * SP + p) * SGC + c) * 2]; bi[c] = BB[((g * SP + p) * SGC + c) * 2 + 1]; }
                const int so = (mc == 0) ? L_XIN : L_ST; float xr = LDSP(float, so)[(w * SP + p) * 2], xi = LDSP(float, so)[(w * SP + p) * 2 + 1];
                for (int i = 0; i < MC; ++i) { const int sx = w * SEGL + mc * MC + i; const U4 u0 = *(const U4*)&LDSP(bf16, L_U)[sx * SGC], u1 = *(const U4*)&LDSP(bf16, L_U)[sx * SGC + 8]; const unsigned uw[8] = {u0.x, u0.y, u0.z, u0.w, u1.x, u1.y, u1.z, u1.w};
                    float ur = 0.f, ui = 0.f;
_Pragma("unroll") for (int c = 0; c < SGC; ++c) { const float uv = bf2f((bf16)((c & 1) ? (uw[c >> 1] >> 16) : (uw[c >> 1] & 0xffffu))); ur += br[c] * uv; ui += bi[c] * uv; }
                    const float nr = abr * xr - abi * xi + ur, ni = abr * xi + abi * xr + ui; xr = nr; xi = ni;
                    LDSP(float, L_XB)[(w * MC + i) * XBS + p * 2] = xr; LDSP(float, L_XB)[(w * MC + i) * XBS + p * 2 + 1] = xi; }
                LDSP(float, L_ST)[(w * SP + p) * 2] = xr; LDSP(float, L_ST)[(w * SP + p) * 2 + 1] = xi; }
            BLOCK_SYNC();
            FOR_THREADS(t) { const int w = t / 64, l = t % 64;
                for (int e = l; e < MC * SGC; e += 64) { const int i = e / SGC, c = e % SGC; float y = 0.f;
                    for (int p = 0; p < SP; ++p) y += LDSP(float, L_CR)[c * CS + p] * LDSP(float, L_XB)[(w * MC + i) * XBS + p * 2] - LDSP(float, L_CI)[c * CS + p] * LDSP(float, L_XB)[(w * MC + i) * XBS + p * 2 + 1];
                    const int sx = w * SEGL + mc * MC + i; const size_t r = (size_t)b * S + sx; y += dskip[g * SGC + c] * bf2f(LDSP(bf16, L_U)[sx * SGC + c]); Y[r * D + g * SGC + c] = f2bf(geluf_(y)); } }
            BLOCK_SYNC();
        }
    }
}
DEV void stage_nsa_prep1(const Ctx& cx, const bf16* RAW, const int* pos, const float* qn, const float* kn, bf16* QN, bf16* KS, bf16* VS, bf16* KW, bf16* VW, bf16* KCR, bf16* VCR, float* GT) {
    constexpr int NTASK = NH + 6 * NG;
    ROW_FOR(q, (size_t)T * NTASK) {
        const size_t r = q / NTASK; const int k = (int)(q % NTASK); const int b = (int)(r / S), s = (int)(r % S);
        const bf16* src; bf16* dst; const float* gain = nullptr;
        if (k < NH) { src = RAW + r * NSA_INP + k * NDH; dst = QN + r * D + k * NDH; gain = qn; }
        else { const int kk = (k - NH) / NG, g = (k - NH) % NG;
            const int colo = kk == 0 ? D + 2 * KVW : kk == 1 ? D + 4 * KVW : kk == 2 ? D + 3 * KVW : kk == 3 ? D + 5 * KVW : kk == 4 ? D : D + KVW;
            bf16* const dstb = kk == 0 ? KS : kk == 1 ? KW : kk == 2 ? VS : kk == 3 ? VW : kk == 4 ? KCR : VCR;
            src = RAW + r * NSA_INP + colo + g * NDH; dst = dstb + (((size_t)b * NG + g) * S + s) * NDH;
            if (kk == 0) gain = kn + NDH; else if (kk == 1) gain = kn + 2 * NDH; }
        if (gain) {
            float ss = 0.f; LANE_FOR(d, NDH) { const float x = bf2f(src[d]); ss += x * x; } ss = WAVE_SUM(ss);
            const float rinv = 1.0f / sqrtf(ss * (1.0f / NDH) + NORM_EPS);
            LANE_FOR(i, NDH / 2) { const float x1 = bf2f(src[i]) * rinv * gain[i], x2 = bf2f(src[i + NDH / 2]) * rinv * gain[i + NDH / 2];
                float cs, sn; rope_cs_((float)pos[r], 2 * i, NDH, cs, sn);
                dst[i] = f2bf(x1 * cs - x2 * sn); dst[i + NDH / 2] = f2bf(x2 * cs + x1 * sn); }
        } else if (k >= NH + 2 * NG && k < NH + 4 * NG) {
        } else { LANE_FOR(d, NDH) dst[d] = src[d]; }
        if (k == 0) { LANE_FOR(i, NH * 3) GT[r * NH * 3 + i] = sigmoidf_(bf2f(RAW[r * NSA_INP + D + 6 * KVW + i])); }
    }
}
constexpr int CBK = 32;
DEV void stage_cmp_bias_part(const Ctx& cx, const float* cpos, const float* w1, float* P) {
    constexpr int NCHK = CK / CBK; static_assert(CK % CBK == 0, "cmp bias chunks");
    ROW_FOR(tk, 2 * NCHK) { const int kv = (int)(tk / NCHK), ch = (int)(tk % NCHK);
        LANE_FOR(j, CHID) { float a = 0.f; for (int k = ch * CBK; k < (ch + 1) * CBK; ++k) a += cpos[(size_t)kv * CK + k] * w1[((size_t)kv * CK + k) * CHID + j];
            P[((size_t)ch * 2 + kv) * CHID + j] = a; } }
}
DEV void stage_cmp_bias_red(const Ctx& cx, const float* P, float* CMPBo) {
    constexpr int NCHK = CK / CBK;
    GRID_FOR(i, 2 * CHID) { float sacc = 0.f; for (int ch = 0; ch < NCHK; ++ch) sacc += P[(size_t)ch * 2 * CHID + i]; CMPBo[i] = sacc; }
}
DEV void stage_cmp2(const Ctx& cx, const bf16* HID, const float* w2, const float* kn, const int* pos, bf16* KC, bf16* VC) {
    ROW_FOR(q, (size_t)2 * NB * NG * NCV) {
        const int c = (int)(q % NCV); size_t q2 = q / NCV; const int bg = (int)(q2 % (NB * NG)); const int kv = (int)(q2 / (NB * NG)); const int b = bg / NG;
        const size_t m = (size_t)bg * NCB + c; const bf16* hp = HID + ((size_t)kv * CMP_M + m) * CHID; const float* wp = w2 + (size_t)kv * CHID * NDH;
        bf16* dst = KC + m * NDH; float ss = 0.f;
        LANE_FOR(d, NDH) { float v = 0.f; for (int j = 0; j < CHID; ++j) v += bf2f(hp[j]) * bf2f(f2bf(wp[j * NDH + d]));
            if (kv) VC[((size_t)bg * NDH + d) * NCB + c] = f2bf(v);
            else { dst[d] = f2bf(v); const float vr = bf2f(dst[d]); ss += vr * vr; } }
        if (kv == 0) {
            ss = WAVE_SUM(ss); const float rinv = 1.0f / sqrtf(ss * (1.0f / NDH) + NORM_EPS); const float pp = (float)pos[(size_t)b * S + c * CSTR];
            LANE_FOR(i, NDH / 2) { const float x1 = bf2f(dst[i]) * rinv * kn[i], x2 = bf2f(dst[i + NDH / 2]) * rinv * kn[i + NDH / 2];
                float cs, sn; rope_cs_(pp, 2 * i, NDH, cs, sn);
                dst[i] = f2bf(x1 * cs - x2 * sn); dst[i + NDH / 2] = f2bf(x2 * cs + x1 * sn); }
        }
    }
}
constexpr int AQT = 16, AQR = AQT * HG, AKT = 128;
DEV void stage_attn(const Ctx& cx, int mode, const bf16* QN, const bf16* Kc, const bf16* Vc, bf16* Out, unsigned* SELM) {
    constexpr int L_Q = 0, L_P = L_Q + AQR * NDH * 4, L_O = L_P + AQR * AKT * 4, L_M = L_O + AQR * NDH * 4, L_L = L_M + AQR * 4, L_A = L_L + AQR * 4, L_IMP = L_A + AQR * 4;
    const float scale = 1.0f / sqrtf((float)NDH);
    constexpr int NU = NB * NG * (S / AQT);
    for (int un = cx.bid; un < NU; un += cx.nblk) {
        const int tb = un % (S / AQT), g = (un / (S / AQT)) % NG, b = un / ((S / AQT) * NG); const int t0 = tb * AQT;
        const size_t kvrow = (mode == 0) ? NCB : S; const bf16* Kb = Kc + ((size_t)b * NG + g) * kvrow * NDH; const bf16* Vb = Vc + ((size_t)b * NG + g) * kvrow * NDH;
        int klo, khi;
        if (mode == 0) { klo = 0; khi = NCV; } else if (mode == 1) { klo = 0; khi = t0 + AQT; } else { klo = t0 - WIN + 1; if (klo < 0) klo = 0; klo = (klo / AKT) * AKT; khi = t0 + AQT; }
        FOR_THREADS(t) {
            for (int e = t; e < AQR * NDH; e += NT) { const int row = e / NDH, d = e % NDH, tl = row / HG, hh = row % HG;
                LDSP(float, L_Q)[e] = bf2f(QN[((size_t)b * S + t0 + tl) * D + (g * HG + hh) * NDH + d]) * scale; LDSP(float, L_O)[e] = 0.f; }
            if (t < AQR) { LDSP(float, L_M)[t] = -INFINITY; LDSP(float, L_L)[t] = 0.f; } }
        BLOCK_SYNC();
        for (int k0 = klo; k0 < khi; k0 += AKT) {
            FOR_THREADS(t) { for (int e = t; e < AQR * AKT; e += NT) { const int row = e / AKT, kk = e % AKT, s = k0 + kk, tt = t0 + row / HG; bool ok = s < khi;
                if (ok) { if (mode == 0) ok = (s * CSTR + CL - 1 <= tt); else if (mode == 1) ok = (s <= tt) && ((SELM[((size_t)b * NG + g) * S + tt] >> (s / SELB)) & 1u); else ok = (s <= tt) && (tt - s < WIN); }
                float sc = -INFINITY;
                if (ok) { sc = 0.f; const bf16* kp = Kb + (size_t)s * NDH; for (int d = 0; d < NDH; ++d) sc += LDSP(float, L_Q)[row * NDH + d] * bf2f(kp[d]); }
                LDSP(float, L_P)[e] = sc; } }
            BLOCK_SYNC();
            FOR_THREADS(t) { if (t < AQR) { float mx = -INFINITY; for (int kk = 0; kk < AKT; ++kk) mx = fmaxf(mx, LDSP(float, L_P)[t * AKT + kk]);
                const float mold = LDSP(float, L_M)[t], mnew = fmaxf(mold, mx); float al = 1.f, sum = 0.f;
                if (mnew == -INFINITY) { for (int kk = 0; kk < AKT; ++kk) LDSP(float, L_P)[t * AKT + kk] = 0.f; }
                else { al = (mold == -INFINITY) ? 0.f : expf(mold - mnew);
                    for (int kk = 0; kk < AKT; ++kk) { const float x = LDSP(float, L_P)[t * AKT + kk]; const float p = (x == -INFINITY) ? 0.f : expf(x - mnew); LDSP(float, L_P)[t * AKT + kk] = p; sum += p; } }
                LDSP(float, L_L)[t] = LDSP(float, L_L)[t] * al + sum; LDSP(float, L_M)[t] = mnew; LDSP(float, L_A)[t] = al; } }
            BLOCK_SYNC();
            FOR_THREADS(t) { for (int e = t; e < AQR * NDH; e += NT) { const int row = e / NDH, d = e % NDH; float a = LDSP(float, L_O)[e] * LDSP(float, L_A)[row];
                const int kmax = (khi - k0) < AKT ? (khi - k0) : AKT;
                for (int kk = 0; kk < kmax; ++kk) a += LDSP(float, L_P)[row * AKT + kk] * bf2f(Vb[(size_t)d * kvrow + (k0 + kk)]);
                LDSP(float, L_O)[e] = a; } }
            BLOCK_SYNC();
        }
        FOR_THREADS(t) { for (int e = t; e < AQR * NDH; e += NT) { const int row = e / NDH, d = e % NDH, tl = row / HG, hh = row % HG; const float l = LDSP(float, L_L)[row];
            Out[((size_t)b * S + t0 + tl) * D + (g * HG + hh) * NDH + d] = f2bf(l > 0.f ? LDSP(float, L_O)[e] / l : 0.f); } }
        if (mode == 0) {
            FOR_THREADS(t) { for (int e = t; e < AQT * NSEL; e += NT) { const int tl = e / NSEL, j = e % NSEL; float imp = 0.f;
                for (int hh = 0; hh < HG; ++hh) { const int row = tl * HG + hh; const float l = LDSP(float, L_L)[row]; if (l > 0.f) { float a = 0.f;
                    for (int c = 0; c < NCV; ++c) { const int cs = c * CSTR, js = j * SELB; const int lo = cs > js ? cs : js, hi = (cs + CL) < (js + SELB) ? (cs + CL) : (js + SELB);
                        if (hi > lo) a += LDSP(float, L_P)[row * AKT + c] * ((float)(hi - lo) / (float)CL); }
                    imp += a / l; } }
                LDSP(float, L_IMP)[e] = imp; } }
            BLOCK_SYNC();
            FOR_THREADS(t) { if (t < AQT) { const int tt = t0 + t, cur = tt / SELB; unsigned mask = 0u;
                if (cur + 1 <= TOPN) { for (int j = 0; j <= cur; ++j) mask |= 1u << j; }
                else { mask = 1u | (1u << cur) | (1u << (cur - 1));
                    for (int j = 1; j <= cur - 2; ++j) { const float v = LDSP(float, L_IMP)[t * NSEL + j]; int rank = 0;
                        for (int j2 = 1; j2 <= cur - 2; ++j2) { const float v2 = LDSP(float, L_IMP)[t * NSEL + j2]; if (v2 > v || (v2 == v && j2 < j)) ++rank; }
                        if (rank < TOPN - 3) mask |= 1u << j; } }
                SELM[((size_t)b * NG + g) * S + tt] = mask; } }
        }
        BLOCK_SYNC();
    }
}
DEV void stage_nsa_combine_host(const Ctx& cx, bf16* OWo, const bf16* OCi, const bf16* OSi, const float* GTi) {
    constexpr int NU = NB * NG * (S / AQT);
    for (int un = cx.bid; un < NU; un += cx.nblk) { const int tb = un % (S / AQT), g = (un / (S / AQT)) % NG, b = un / ((S / AQT) * NG);
        for (int tl = 0; tl < AQT; ++tl) for (int hh = 0; hh < HG; ++hh) { const size_t r = (size_t)b * S + tb * AQT + tl; const int h = g * HG + hh; const float* gp = GTi + (r * NH + h) * 3;
            for (int d = 0; d < NDH; ++d) { const size_t e = r * D + h * NDH + d; OWo[e] = f2bf(gp[0] * bf2f(OCi[e]) + gp[1] * bf2f(OSi[e]) + gp[2] * bf2f(OWo[e])); } } }
}
#ifndef HOST_SIM
__device__ __forceinline__ void nsa_prep1_gpu(const Ctx& cx, const bf16* RAW, const int* pos, const float* qn, const float* kn, bf16* QNo, bf16* KSo, bf16* KWo, bf16* KCRo, bf16* VCRo, float* GTo) {
    static_assert(NDH == 128 && NH == 8 && NG == 2, "nsa prep geometry");
    const int grp = cx.lane >> 4, l16 = cx.lane & 15;
    for (long r = (long)cx.bid * NWV + cx.wave; r < (long)T; r += (long)cx.nblk * NWV) {
        const int b = (int)(r / S), sx = (int)(r % S);
        U4 raws[4];
#pragma unroll
        for (int q = 0; q < 4; ++q) { const int k = q * 4 + grp; int colo;
            if (k < 8) colo = k * NDH; else { const int kk = (k - 8) >> 1, g = (k - 8) & 1; colo = (kk == 0 ? D + 2 * KVW : kk == 1 ? D + 4 * KVW : kk == 2 ? D : D + KVW) + g * NDH; }
            raws[q] = *(const U4*)(RAW + r * NSA_INP + colo + l16 * 8); }
        const float pp = (float)pos[r];
#pragma unroll
        for (int q = 0; q < 4; ++q) { const int k = q * 4 + grp;
        bf16* dst; const float* gain = nullptr;
        if (k < 8) { dst = QNo + r * D + k * NDH; gain = qn; }
        else { const int kk = (k - 8) >> 1, g = (k - 8) & 1;
            dst = (kk == 0 ? KSo : kk == 1 ? KWo : kk == 2 ? KCRo : VCRo) + (((size_t)b * NG + g) * S + sx) * NDH;
            if (kk == 0) gain = kn + NDH; else if (kk == 1) gain = kn + 2 * NDH; }
        const U4 raw = raws[q];
        if (gain) {
            const unsigned w[4] = {raw.x, raw.y, raw.z, raw.w}; float x[8], ss = 0.f;
#pragma unroll
            for (int e = 0; e < 8; ++e) { x[e] = bf2f((bf16)((e & 1) ? (w[e >> 1] >> 16) : (w[e >> 1] & 0xffffu))); ss += x[e] * x[e]; }
            ss += __shfl_xor(ss, 1); ss += __shfl_xor(ss, 2); ss += __shfl_xor(ss, 4); ss += __shfl_xor(ss, 8);
            const float rinv = 1.0f / sqrtf(ss * (1.0f / NDH) + NORM_EPS);
            float y[8], yp[8];
#pragma unroll
            for (int e = 0; e < 8; ++e) y[e] = x[e] * rinv * gain[l16 * 8 + e];
#pragma unroll
            for (int e = 0; e < 8; ++e) yp[e] = __shfl_xor(y[e], 8);
            float o[8];
#pragma unroll
            for (int e = 0; e < 8; ++e) { float cs, sn; rope_cs_(pp, 2 * ((l16 & 7) * 8 + e), NDH, cs, sn); o[e] = (l16 < 8) ? (y[e] * cs - yp[e] * sn) : (y[e] * cs + yp[e] * sn); }
            U4 ow; ow.x = pk2(o[0], o[1]); ow.y = pk2(o[2], o[3]); ow.z = pk2(o[4], o[5]); ow.w = pk2(o[6], o[7]);
            *(U4*)(dst + l16 * 8) = ow;
        } else { *(U4*)(dst + l16 * 8) = raw; }
        }
    }
    GRID_FOR(i, (size_t)T * NH * 3) { const size_t r = i / (NH * 3); const int j = (int)(i % (NH * 3)); GTo[i] = sigmoidf_(bf2f(RAW[r * NSA_INP + D + 6 * KVW + j])); }
}
#define NSAPREP1(raw, pos, qn, kn, q, ks, vs, kw, vw, kcr, vcr, gt) nsa_prep1_gpu(cx, raw, pos, qn, kn, q, ks, kw, kcr, vcr, gt)
#else
#define NSAPREP1(raw, pos, qn, kn, q, ks, vs, kw, vw, kcr, vcr, gt) stage_nsa_prep1(cx, raw, pos, qn, kn, q, ks, vs, kw, vw, kcr, vcr, gt)
#endif
#ifndef HOST_SIM
DEV void prep_w2t(const Ctx& cx, const float* w2, bf16* W2T) {
    GRID_FOR(e, (size_t)2 * NDH * CHID) { const int k = (int)(e % CHID), n = (int)((e / CHID) % NDH), kv = (int)(e / ((size_t)CHID * NDH)); W2T[e] = f2bf(w2[((size_t)kv * CHID + k) * NDH + n]); }
}
__device__ __forceinline__ void cmp2_gpu(const Ctx& cx, const bf16* HID, const bf16* W2T, const float* kn, const int* pos, bf16* KC, bf16* VC) {
    static_assert(NDH == 128 && CHID % 32 == 0 && CMP_M % 16 == 0, "cmp2 geometry");
    typedef short bf16x8_ __attribute__((ext_vector_type(8))); typedef float f32x4_ __attribute__((ext_vector_type(4)));
    const int l16 = cx.lane & 15, lg = cx.lane >> 4; constexpr int NTL = 2 * (CMP_M / 16);
    for (int it = cx.bid + cx.nblk * cx.wave; it < NTL; it += cx.nblk * NWV) {
        const int kv = it / (CMP_M / 16), m = (it % (CMP_M / 16)) * 16 + l16; const int c = m % NCB, bg = m / NCB;
        const bf16* hp = HID + ((size_t)kv * CMP_M + m) * CHID + lg * 8; const bf16* wp = W2T + ((size_t)kv * NDH + l16) * CHID + lg * 8;
        f32x4_ acc[8];
#pragma unroll
        for (int nb = 0; nb < 8; ++nb) acc[nb] = (f32x4_){0.f, 0.f, 0.f, 0.f};
#pragma unroll 2
        for (int kb = 0; kb < CHID / 32; ++kb) { const bf16x8_ hb = *(const bf16x8_*)(hp + kb * 32);
#pragma unroll
            for (int nb = 0; nb < 8; ++nb) { const bf16x8_ wa = *(const bf16x8_*)(wp + (size_t)nb * 16 * CHID + kb * 32); acc[nb] = __builtin_amdgcn_mfma_f32_16x16x32_bf16(wa, hb, acc[nb], 0, 0, 0); } }
        if (c < NCV) {
            if (kv) {
#pragma unroll
                for (int nb = 0; nb < 8; ++nb)
#pragma unroll
                    for (int i = 0; i < 4; ++i) VC[((size_t)bg * NDH + nb * 16 + lg * 4 + i) * NCB + c] = f2bf(acc[nb][i]);
            }
        }
        if (!kv) {
            float ss = 0.f;
#pragma unroll
            for (int nb = 0; nb < 8; ++nb)
#pragma unroll
                for (int i = 0; i < 4; ++i) { const float vr = bf2f(f2bf(acc[nb][i])); acc[nb][i] = vr; ss += vr * vr; }
            ss += __shfl_xor(ss, 16); ss += __shfl_xor(ss, 32);
            const float rinv = 1.0f / sqrtf(ss * (1.0f / NDH) + NORM_EPS); const float pp = (float)pos[(size_t)(bg / NG) * S + (c < NCV ? c : 0) * CSTR];
            bf16* dst = KC + (size_t)m * NDH + lg * 4;
#pragma unroll
            for (int nb = 0; nb < 4; ++nb) { float o1[4], o2[4];
#pragma unroll
                for (int i = 0; i < 4; ++i) { const int d = nb * 16 + lg * 4 + i; const float x1 = acc[nb][i] * rinv * kn[d], x2 = acc[nb + 4][i] * rinv * kn[d + NDH / 2];
                    float cs, sn; rope_cs_(pp, 2 * d, NDH, cs, sn); o1[i] = x1 * cs - x2 * sn; o2[i] = x2 * cs + x1 * sn; }
                if (c < NCV) { U2 a, b2; a.x = pk2(o1[0], o1[1]); a.y = pk2(o1[2], o1[3]); b2.x = pk2(o2[0], o2[1]); b2.y = pk2(o2[2], o2[3]);
                    *(U2*)(dst + nb * 16) = a; *(U2*)(dst + nb * 16 + NDH / 2) = b2; } }
        }
    }
}
#define CMP2(hid, w2f, w2t, kn, pos, kc, vc) cmp2_gpu(cx, hid, w2t, kn, pos, kc, vc)
#define PREP_W2T(w2, w2t) prep_w2t(cx, w2, w2t)
#else
#define PREP_W2T(w2, w2t) do {} while (0)
#define CMP2(hid, w2f, w2t, kn, pos, kc, vc) stage_cmp2(cx, hid, w2f, kn, pos, kc, vc)
#endif
#ifndef HOST_SIM
namespace att {
typedef short bf16x8 __attribute__((ext_vector_type(8)));
typedef float f32x16 __attribute__((ext_vector_type(16)));
typedef unsigned u32x4 __attribute__((ext_vector_type(4)));
constexpr int L_K = 0, L_V = 16384, L_B2 = 32768, L_W = 65536, WSCR = 1280;
__device__ __forceinline__ int kswz(int row, int colB) { return row * 256 + (colB ^ ((row & 7) << 4)); }
__device__ __forceinline__ int vswz(int row, int colB) { return row * 128 + (colB ^ ((row & 7) << 4)); }
__device__ __forceinline__ int crow(int r, int hi) { return (r & 3) + 8 * (r >> 2) + 4 * hi; }
__device__ __forceinline__ unsigned cvtpk(float lo, float hi) { unsigned r; asm volatile("v_cvt_pk_bf16_f32 %0, %1, %2" : "=v"(r) : "v"(lo), "v"(hi)); return r; }
__device__ __forceinline__ float swapmax(float v) { auto rr = __builtin_amdgcn_permlane32_swap(__float_as_uint(v), __float_as_uint(v), false, false); return fmaxf(__uint_as_float(rr[0]), __uint_as_float(rr[1])); }
__device__ __forceinline__ float swapsum(float v) { auto rr = __builtin_amdgcn_permlane32_swap(__float_as_uint(v), __float_as_uint(v), false, false); return __uint_as_float(rr[0]) + __uint_as_float(rr[1]); }
#define ATT_PK4(P, B_, OUT) do { unsigned a0 = cvtpk(P[B_ + 0], P[B_ + 1]), a1 = cvtpk(P[B_ + 2], P[B_ + 3]); unsigned b0 = cvtpk(P[B_ + 4], P[B_ + 5]), b1 = cvtpk(P[B_ + 6], P[B_ + 7]); \
        auto r0 = __builtin_amdgcn_permlane32_swap(a0, b0, false, false); auto r1 = __builtin_amdgcn_permlane32_swap(a1, b1, false, false); \
        u32x4 w = {r0[0], r1[0], r0[1], r1[1]}; OUT = *reinterpret_cast<bf16x8*>(&w); } while (0)
template <int MODE>
__device__ __forceinline__ void attn_mfma(const Ctx& cx, const bf16* QNp, const bf16* Kc, const bf16* Vt, bf16* Out, unsigned* SELMp, const bf16* OCp = nullptr, const bf16* OSp = nullptr, const float* GTp = nullptr) {
    static_assert(NDH == 128 && HG == 4 && SELB == 64 && NB * NG * 8 == 256 && S == 2048, "attention body geometry");
    const int tid = cx.tid, wid = cx.wave, lane = cx.lane, r32 = lane & 31, hi = lane >> 5;
    LAS unsigned char* lds = cx.lds;
    LAS float* wsc = (LAS float*)(lds + L_W + wid * WSCR); LAS float* al_l = wsc; LAS float* li_l = wsc + 32; LAS float* impw = wsc + 64;
    constexpr int KROWS = MODE == 0 ? NCB : S, NTB = S / 64, NUNITS = NB * NG * NTB;
    constexpr float C2 = 1.4426950408889634f * 0.08838834764831845f;
    const float NEG = -__builtin_inff();
    for (int it = 0;; ++it) {
        const int u = it * cx.nblk + cx.bid; if (u >= NUNITS) break;
        int bg, tb;
        if (cx.nblk == 256) { const int xcd = cx.bid & 7, li = cx.bid >> 3; bg = xcd * 4 + (li >> 3); const int x = li & 7;
            tb = it == 0 ? x : it == 1 ? 15 - x : it == 2 ? 16 + x : 31 - x; }
        else { bg = u / NTB; tb = u % NTB; }
        const int b = bg / NG, g = bg % NG, t0 = tb * 64;
        const int row = wid * 32 + r32, pos = t0 + (row >> 2);
        const bf16* qp = QNp + ((size_t)b * S + pos) * D + (g * HG + (row & 3)) * NDH;
        bf16x8 qr[8];
#pragma unroll
        for (int d0 = 0; d0 < 8; ++d0) qr[d0] = *(const bf16x8*)(qp + d0 * 16 + hi * 8);
        int klo = 0, khi = pos, j_lo = 0, j_hi = tb + 1; unsigned tmask = 0xffffffffu;
        if (MODE == 0) { khi = pos >= CL - 1 ? (pos - (CL - 1)) / CSTR : -1; if (khi > NCV - 1) khi = NCV - 1; j_hi = (NCV + 63) / 64; }
        else if (MODE == 1) { tmask = SELMp[(size_t)bg * S + pos]; }
        else { klo = pos - WIN + 1; const int lk = t0 - WIN + 1; j_lo = lk > 0 ? lk / 64 : 0; }
        float m_reg = -1e30f, l_reg = 0.f; f32x16 o[4] = {}; f32x16 oi = {};
        const bf16* Kb = Kc + (size_t)bg * KROWS * NDH; const bf16* Vb = Vt + (size_t)bg * NDH * KROWS;
        u32x4 pk[2], pv[2];
#define ATT_LOAD(j_) do { _Pragma("unroll") for (int i = 0; i < 2; ++i) { const int p = tid + 512 * i; pk[i] = *(const u32x4*)(Kb + (size_t)((j_) * 64 + (p >> 4)) * NDH + (p & 15) * 8); \
            pv[i] = *(const u32x4*)(Vb + (size_t)(p >> 3) * KROWS + (j_) * 64 + (p & 7) * 8); } } while (0)
#define ATT_PUT(boff_) do { _Pragma("unroll") for (int i = 0; i < 2; ++i) { const int p = tid + 512 * i; \
            *(LAS u32x4*)(lds + (boff_) + L_K + kswz(p >> 4, (p & 15) * 16)) = pk[i]; *(LAS u32x4*)(lds + (boff_) + L_V + vswz(p >> 3, (p & 7) * 16)) = pv[i]; } } while (0)
        if (MODE != 0) { __syncthreads();
            ATT_LOAD(j_lo); ATT_PUT(0); if (j_lo + 1 < j_hi) ATT_LOAD(j_lo + 1); }
        for (int j = j_lo; j < j_hi; ++j) {
            int boff = 0;
            if (MODE == 0) {
                __syncthreads();
                ATT_LOAD(j); ATT_PUT(0);
                __syncthreads();
            } else {
                __syncthreads();
                boff = ((j - j_lo) & 1) * L_B2;
                if (j + 1 < j_hi) { ATT_PUT(L_B2 - boff); if (j + 2 < j_hi) ATT_LOAD(j + 2); }
            }
            f32x16 p0 = {}, p1 = {};
#pragma unroll
            for (int d0 = 0; d0 < 8; ++d0) { const int ko = kswz(r32, (d0 * 16 + hi * 8) * 2);
                const bf16x8 k0 = *(const LAS bf16x8*)(lds + boff + L_K + ko), k1 = *(const LAS bf16x8*)(lds + boff + L_K + ko + 32 * 256);
                p0 = __builtin_amdgcn_mfma_f32_32x32x16_bf16(k0, qr[d0], p0, 0, 0, 0); p1 = __builtin_amdgcn_mfma_f32_32x32x16_bf16(k1, qr[d0], p1, 0, 0, 0); }
            { const bool tok = (tmask >> j) & 1u; const int kb = j * 64 + 4 * hi;
              const bool inner = tok && (j * 64 >= klo) && (j * 64 + 63 <= khi);
              if (!__all(inner)) {
#pragma unroll
              for (int r = 0; r < 16; ++r) { const int k0 = kb + (r & 3) + 8 * (r >> 2), k1 = k0 + 32;
                  if (!(tok && k0 >= klo && k0 <= khi)) p0[r] = NEG; if (!(tok && k1 >= klo && k1 <= khi)) p1[r] = NEG; } } }
            float pmax = p0[0];
#pragma unroll
            for (int r = 1; r < 16; ++r) pmax = fmaxf(pmax, p0[r]);
#pragma unroll
            for (int r = 0; r < 16; ++r) pmax = fmaxf(pmax, p1[r]);
            pmax = swapmax(pmax);
            const float mn = fmaxf(m_reg, pmax), alpha = __builtin_amdgcn_exp2f((m_reg - mn) * C2), mnL = -mn * C2; m_reg = mn;
            float ps = 0.f;
#pragma unroll
            for (int r = 0; r < 16; ++r) { p0[r] = __builtin_amdgcn_exp2f(fmaf(p0[r], C2, mnL)); p1[r] = __builtin_amdgcn_exp2f(fmaf(p1[r], C2, mnL)); ps += p0[r] + p1[r]; }
            ps = swapsum(ps); l_reg = l_reg * alpha + ps;
            bf16x8 pa0, pa1, pa2, pa3;
            ATT_PK4(p0, 0, pa0); ATT_PK4(p0, 8, pa1); ATT_PK4(p1, 0, pa2); ATT_PK4(p1, 8, pa3);
            if (__any(alpha < 1.f)) { if (hi == 0) al_l[r32] = alpha; asm volatile("s_waitcnt lgkmcnt(0)" ::: "memory");
#pragma unroll
                for (int r = 0; r < 16; ++r) { const float a = al_l[crow(r, hi)];
#pragma unroll
                    for (int d = 0; d < 4; ++d) o[d][r] *= a;
                    if (MODE == 0) oi[r] *= a; } }
#pragma unroll
            for (int d0 = 0; d0 < 4; ++d0) { const int rd = d0 * 32 + r32;
                const bf16x8 v0 = *(const LAS bf16x8*)(lds + boff + L_V + vswz(rd, (0 + 8 * hi) * 2)), v1 = *(const LAS bf16x8*)(lds + boff + L_V + vswz(rd, (16 + 8 * hi) * 2)),
                             v2 = *(const LAS bf16x8*)(lds + boff + L_V + vswz(rd, (32 + 8 * hi) * 2)), v3 = *(const LAS bf16x8*)(lds + boff + L_V + vswz(rd, (48 + 8 * hi) * 2));
                o[d0] = __builtin_amdgcn_mfma_f32_32x32x16_bf16(pa0, v0, o[d0], 0, 0, 0); o[d0] = __builtin_amdgcn_mfma_f32_32x32x16_bf16(pa1, v1, o[d0], 0, 0, 0);
                o[d0] = __builtin_amdgcn_mfma_f32_32x32x16_bf16(pa2, v2, o[d0], 0, 0, 0); o[d0] = __builtin_amdgcn_mfma_f32_32x32x16_bf16(pa3, v3, o[d0], 0, 0, 0); }
            if (MODE == 0) {
#pragma unroll
                for (int kk = 0; kk < 4; ++kk) { float mv[8];
#pragma unroll
                    for (int i = 0; i < 8; ++i) { const int c = j * 64 + kk * 16 + 8 * hi + i, cs = c * CSTR, js = r32 * SELB; const int lo = cs > js ? cs : js, hiE = (cs + CL) < (js + SELB) ? (cs + CL) : (js + SELB);
                        mv[i] = hiE > lo ? (float)(hiE - lo) * (1.0f / CL) : 0.f; }
                    u32x4 w = {cvtpk(mv[0], mv[1]), cvtpk(mv[2], mv[3]), cvtpk(mv[4], mv[5]), cvtpk(mv[6], mv[7])}; const bf16x8 mf = *reinterpret_cast<bf16x8*>(&w);
                    oi = __builtin_amdgcn_mfma_f32_32x32x16_bf16(kk == 0 ? pa0 : kk == 1 ? pa1 : kk == 2 ? pa2 : pa3, mf, oi, 0, 0, 0); } }
        }
        if (hi == 0) li_l[r32] = l_reg; asm volatile("s_waitcnt lgkmcnt(0)" ::: "memory");
        float rli[16];
#pragma unroll
        for (int r = 0; r < 16; ++r) { const float l = li_l[crow(r, hi)]; rli[r] = l > 0.f ? __builtin_amdgcn_rcpf(l) : 0.f; }
        if (MODE == 2 && GTp) {
#pragma unroll
            for (int rh = 0; rh < 16; rh += 8) {
                float gg0[8], gg1[8], gg2[8];
#pragma unroll
                for (int k = 0; k < 8; ++k) { const int r = rh + k, R = wid * 32 + crow(r, hi); const size_t tokr = (size_t)b * S + t0 + (R >> 2); const float* gp = GTp + (tokr * NH + g * HG + (R & 3)) * 3;
                    gg0[k] = gp[0]; gg1[k] = gp[1]; gg2[k] = gp[2] * rli[r]; }
#pragma unroll
                for (int d0 = 0; d0 < 4; ++d0) { bf16 coc[8], cos_[8];
#pragma unroll
                    for (int k = 0; k < 8; ++k) { const int r = rh + k, R = wid * 32 + crow(r, hi); const size_t eo = ((size_t)b * S + t0 + (R >> 2)) * D + (g * HG + (R & 3)) * NDH + d0 * 32 + r32; coc[k] = OCp[eo]; cos_[k] = OSp[eo]; }
#pragma unroll
                    for (int k = 0; k < 8; ++k) { const int r = rh + k, R = wid * 32 + crow(r, hi); const size_t eo = ((size_t)b * S + t0 + (R >> 2)) * D + (g * HG + (R & 3)) * NDH + d0 * 32 + r32;
                        const float v = gg2[k] * o[d0][r] + gg0[k] * bf2f(coc[k]) + gg1[k] * bf2f(cos_[k]); const float vn = __shfl_xor(v, 1);
                        if ((r32 & 1) == 0) *(unsigned*)(Out + eo) = cvtpk(v, vn); } } }
        } else {
#pragma unroll
        for (int r = 0; r < 16; ++r) { const int R = wid * 32 + crow(r, hi); const size_t tokr = (size_t)b * S + t0 + (R >> 2); const size_t eo = tokr * D + (g * HG + (R & 3)) * NDH; bf16* op = Out + eo;
#pragma unroll
            for (int d0 = 0; d0 < 4; ++d0) { const float v = o[d0][r] * rli[r]; const float vn = __shfl_xor(v, 1);
                if ((r32 & 1) == 0) *(unsigned*)(op + d0 * 32 + r32) = cvtpk(v, vn); } }
        }
        if (MODE == 0) {
#pragma unroll
            for (int q = 0; q < 4; ++q) { const float sm = oi[4 * q] * rli[4 * q] + oi[4 * q + 1] * rli[4 * q + 1] + oi[4 * q + 2] * rli[4 * q + 2] + oi[4 * q + 3] * rli[4 * q + 3];
                impw[(2 * q + hi) * 32 + r32] = sm; }
            asm volatile("s_waitcnt lgkmcnt(0)" ::: "memory");
#pragma unroll
            for (int i = 0; i < 4; ++i) { const int tk = 2 * i + hi, jb = r32; bool sel = false;
                if (tb + 1 <= TOPN) sel = jb <= tb;
                else if (jb == 0 || jb == tb || jb == tb - 1) sel = true;
                else if (jb < tb - 1) { const float v = impw[tk * 32 + jb]; int rank = 0;
                    for (int j2 = 1; j2 <= tb - 2; ++j2) { const float v2 = impw[tk * 32 + j2]; rank += (v2 > v || (v2 == v && j2 < jb)) ? 1 : 0; }
                    sel = rank < TOPN - 3; }
                const unsigned long long bal = __ballot(sel);
                if (lane == 0) { SELMp[(size_t)bg * S + t0 + wid * 8 + 2 * i] = (unsigned)bal; SELMp[(size_t)bg * S + t0 + wid * 8 + 2 * i + 1] = (unsigned)(bal >> 32); } }
        }
    }
    __syncthreads();
}
#undef ATT_PK4
#undef ATT_LOAD
#undef ATT_PUT
}
namespace s5 {
typedef short bf16x4 __attribute__((ext_vector_type(4)));
typedef short bf16x8 __attribute__((ext_vector_type(8)));
typedef float f32x4 __attribute__((ext_vector_type(4)));
typedef unsigned u32x2 __attribute__((ext_vector_type(2)));
typedef unsigned u32x4 __attribute__((ext_vector_type(4)));
__device__ __forceinline__ void core_mfma(const Ctx& cx, const bf16* U, bf16* Y, const float* AB, const float* BB, const float* c_re, const float* c_im, const float* dskip) {
    static_assert(SP == 64 && SGC == 16 && NT == 512 && S == 2048, "s5 body geometry");
    constexpr int NSEG = 8, SEGL = S / NSEG, MC = 16, RS = 132, TILEB = MC * RS * 4, L_XEND = NSEG * TILEB, L_XIN = L_XEND + NSEG * SP * 8;
    const int w = cx.wave, lane = cx.lane, fr = lane & 15, fq = lane >> 4;
    LAS float* tile = (LAS float*)(cx.lds + w * TILEB);
    LAS float* xend = (LAS float*)(cx.lds + L_XEND); LAS float* xin = (LAS float*)(cx.lds + L_XIN);
    constexpr int UPW = 4;
    for (int un0 = cx.bid * UPW; un0 < NB * SG; un0 += cx.nblk * UPW)
    for (int un = un0; un < un0 + UPW && un < NB * SG; ++un) {
        const int g = un % SG, b = un / SG;
        const float abr = AB[(g * SP + lane) * 4], abi = AB[(g * SP + lane) * 4 + 1];
        bf16x4 bB[8];
#pragma unroll
        for (int j = 0; j < 8; ++j) { const int n = 16 * j + fr, p_ = n & 63, ri = n >> 6; const float* bp = BB + ((size_t)(g * SP + p_) * SGC + 4 * fq) * 2 + ri;
            const u32x2 v = {pk2(bp[0], bp[2]), pk2(bp[4], bp[6])}; bB[j] = *reinterpret_cast<const bf16x4*>(&v); }
        bf16x8 cB[4];
#pragma unroll
        for (int kk = 0; kk < 4; ++kk) { const int k0 = 32 * kk + 8 * fq; const float* cp = (k0 < 64 ? c_re : c_im) + ((size_t)g * SGC + fr) * SP + (k0 & 63); const float sg = k0 < 64 ? 1.f : -1.f;
            const u32x4 v = {pk2(sg * cp[0], sg * cp[1]), pk2(sg * cp[2], sg * cp[3]), pk2(sg * cp[4], sg * cp[5]), pk2(sg * cp[6], sg * cp[7])}; cB[kk] = *reinterpret_cast<const bf16x8*>(&v); }
        bf16x4 dB;
        { const float dv = dskip[g * SGC + fr]; const u32x2 v = {pk2(4 * fq + 0 == fr ? dv : 0.f, 4 * fq + 1 == fr ? dv : 0.f), pk2(4 * fq + 2 == fr ? dv : 0.f, 4 * fq + 3 == fr ? dv : 0.f)}; dB = *reinterpret_cast<const bf16x4*>(&v); }
        const bf16* ub = U + ((size_t)b * S + (size_t)w * SEGL + fr) * D + g * SGC + 4 * fq;
        float xr = 0.f, xi = 0.f;
#pragma nounroll
        for (int pass = 0; pass < 2; ++pass) {
            if (pass == 1) { xr = xin[(w * SP + lane) * 2]; xi = xin[(w * SP + lane) * 2 + 1]; }
            u32x2 unext = *(const u32x2*)ub;
#pragma nounroll
            for (int ch = 0; ch < SEGL / MC; ++ch) {
                const u32x2 uraw = unext; const bf16x4 aU = *reinterpret_cast<const bf16x4*>(&uraw);
                if (ch + 1 < SEGL / MC) unext = *(const u32x2*)(ub + (size_t)(ch + 1) * MC * D);
#pragma unroll
                for (int j = 0; j < 8; ++j) { const f32x4 acc = __builtin_amdgcn_mfma_f32_16x16x16bf16_1k(aU, bB[j], (f32x4){0.f, 0.f, 0.f, 0.f}, 0, 0, 0);
#pragma unroll
                    for (int i = 0; i < 4; ++i) tile[(4 * fq + i) * RS + 16 * j + fr] = acc[i]; }
                asm volatile("s_waitcnt lgkmcnt(0)" ::: "memory");
#pragma unroll
                for (int t = 0; t < MC; ++t) { const float br = tile[t * RS + lane], bi = tile[t * RS + 64 + lane];
                    const float nr = abr * xr - abi * xi + br, ni = abr * xi + abi * xr + bi; xr = nr; xi = ni;
                    if (pass == 1) { tile[t * RS + lane] = xr; tile[t * RS + 64 + lane] = xi; } }
                if (pass == 1) {
                    asm volatile("s_waitcnt lgkmcnt(0)" ::: "memory");
                    f32x4 ya = __builtin_amdgcn_mfma_f32_16x16x16bf16_1k(aU, dB, (f32x4){0.f, 0.f, 0.f, 0.f}, 0, 0, 0);
#pragma unroll
                    for (int kk = 0; kk < 4; ++kk) { const f32x4 x0 = *(const LAS f32x4*)(tile + fr * RS + 32 * kk + 8 * fq), x1 = *(const LAS f32x4*)(tile + fr * RS + 32 * kk + 8 * fq + 4);
                        const u32x4 v = {pk2(x0[0], x0[1]), pk2(x0[2], x0[3]), pk2(x1[0], x1[1]), pk2(x1[2], x1[3])};
                        ya = __builtin_amdgcn_mfma_f32_16x16x32_bf16(*reinterpret_cast<const bf16x8*>(&v), cB[kk], ya, 0, 0, 0); }
                    bf16* yp = Y + ((size_t)b * S + (size_t)w * SEGL + ch * MC + 4 * fq) * D + g * SGC + fr;
#pragma unroll
                    for (int i = 0; i < 4; ++i) yp[(size_t)i * D] = f2bf(geluf_(ya[i]));
                    asm volatile("s_waitcnt lgkmcnt(0)" ::: "memory");
                }
            }
            if (pass == 0) {
                xend[(w * SP + lane) * 2] = xr; xend[(w * SP + lane) * 2 + 1] = xi;
                __syncthreads();
                if (w == 0) { const float pr = AB[(g * SP + lane) * 4 + 2], pi = AB[(g * SP + lane) * 4 + 3]; float cr = 0.f, ci = 0.f;
                    for (int q = 0; q < NSEG; ++q) { xin[(q * SP + lane) * 2] = cr; xin[(q * SP + lane) * 2 + 1] = ci; const float er = xend[(q * SP + lane) * 2], ei = xend[(q * SP + lane) * 2 + 1];
                        const float nr = pr * cr - pi * ci + er, ni = pr * ci + pi * cr + ei; cr = nr; ci = ni; } }
                __syncthreads();
            }
        }
        __syncthreads();
    }
}
}
#define S5CORE(u, y, ab, bb, cre, cim, dsk) s5::core_mfma(cx, u, y, ab, bb, cre, cim, dsk)
namespace ret {
using att::bf16x8; using att::f32x16; using att::u32x4; using att::cvtpk; using att::crow;
__device__ __forceinline__ int rtswz(int v, int chunk) { return v * 512 + ((chunk ^ (v & 15)) << 4); }
#define RET_PK4(P, B_, OUT) do { unsigned a0 = cvtpk(P[B_ + 0], P[B_ + 1]), a1 = cvtpk(P[B_ + 2], P[B_ + 3]); unsigned b0 = cvtpk(P[B_ + 4], P[B_ + 5]), b1 = cvtpk(P[B_ + 6], P[B_ + 7]); \
        auto r0 = __builtin_amdgcn_permlane32_swap(a0, b0, false, false); auto r1 = __builtin_amdgcn_permlane32_swap(a1, b1, false, false); \
        u32x4 w = {r0[0], r1[0], r0[1], r1[1]}; OUT = *reinterpret_cast<bf16x8*>(&w); } while (0)
__device__ __forceinline__ void core_mfma(const Ctx& cx, const bf16* RAW, const bf16* KT, const bf16* VT, bf16* O) {
    static_assert(RDK == 256 && RDV == 512 && RC == 64 && RH == 4 && S % RC == 0, "retention body geometry");
    const int tid = cx.tid, wid = cx.wave, lane = cx.lane, r32 = lane & 31, hi = lane >> 5;
    LAS unsigned char* lds = cx.lds;
    constexpr int NU = NB * RH * 4, NCH = S / RC, L_Q = 65536, L_K = 98304, L_V = 131072;
    const unsigned qk_voff = (unsigned)(((tid >> 5) * RIN + (tid & 31) * 8) * 2);
    const int qk_lds = (tid >> 5) * 512 + (((tid & 31) ^ ((tid >> 5) & 15)) << 4);
    const int vj = tid & 63, vc = tid >> 6;
    for (int un0 = cx.bid; un0 < NU; un0 += cx.nblk) {
        int un = un0; if (cx.nblk == 256) un = ((un0 & 7) * 8 + (un0 >> 5)) * 4 + ((un0 >> 3) & 3);
        const int vs = un & 3, h = (un >> 2) & 3, b = un >> 4;
        const float lg2 = log2_gamma_(h), cd = __builtin_amdgcn_exp2f((float)RC * lg2), rcd = 1.0f / cd;
        const int ib = wid >> 2, vb = wid & 3;
        f32x16 Racc[4] = {};
        const char* qbase = (const char*)(RAW + (size_t)b * S * RIN + h * RDK); const char* kbase = (const char*)(RAW + (size_t)b * S * RIN + RH * RDK + h * RDK);
        const char* vbase = (const char*)(RAW + (size_t)b * S * RIN + 2 * RH * RDK + h * RDV + vs * 128);
        const bf16* ktrow = KT + ((size_t)b * RH * RDK + h * RDK + 32 * wid + r32) * S;
        u32x4 pq[4], pk[4], pv[2];
#define RET_LOAD(n_) do { _Pragma("unroll") for (int i_ = 0; i_ < 4; ++i_) { const size_t ro_ = ((size_t)(n_) * RC + 16 * i_) * RIN * 2; pq[i_] = *(const u32x4*)(qbase + ro_ + qk_voff); pk[i_] = *(const u32x4*)(kbase + ro_ + qk_voff); } \
        _Pragma("unroll") for (int i_ = 0; i_ < 2; ++i_) pv[i_] = *(const u32x4*)(vbase + ((size_t)(n_) * RC + vj) * RIN * 2 + (vc + 8 * i_) * 16); } while (0)
#define RET_PUT_QK() do { _Pragma("unroll") for (int i_ = 0; i_ < 4; ++i_) { *(LAS u32x4*)(lds + L_Q + qk_lds + i_ * 8192) = pq[i_]; *(LAS u32x4*)(lds + L_K + qk_lds + i_ * 8192) = pk[i_]; } } while (0)
#define RET_PUT_V() do { int vj_ = vj; asm volatile("" : "+v"(vj_));   _Pragma("unroll") for (int i_ = 0; i_ < 2; ++i_) { _Pragma("unroll") for (int e_ = 0; e_ < 8; ++e_) { const int v_ = (vc + 8 * i_) * 8 + e_; \
            const unsigned w_ = pv[i_][e_ >> 1]; *(LAS unsigned short*)(lds + L_V + v_ * 128 + ((((vj_ >> 3) ^ (v_ & 7))) << 4) + (vj_ & 7) * 2) = (unsigned short)((e_ & 1) ? (w_ >> 16) : (w_ & 0xffffu)); } } } while (0)
        { unsigned z0 = 0u; asm volatile("" : "+v"(z0));
          for (int idx = tid; idx < 65536 / 16; idx += NT) *(LAS u32x4*)(lds + idx * 16) = (u32x4){z0, z0, z0, z0}; }
        RET_LOAD(0); RET_PUT_QK(); RET_PUT_V();
        __syncthreads();
        const int qrow = L_Q + (32 * ib + r32) * 512, rx = r32 & 15, vrow = L_V + (32 * vb + r32) * 128, vx = r32 & 7;
#pragma nounroll
        for (int n = 0; n < NCH; ++n) {
            const size_t r0 = (size_t)b * S + (size_t)n * RC;
            f32x16 o = {};
#pragma unroll
            for (int kk = 0; kk < 16; ++kk) { const int ch = 2 * kk + hi;
                const bf16x8 qf = *(const LAS bf16x8*)(lds + qrow + ((ch ^ rx) << 4)), rb = *(const LAS bf16x8*)(lds + rtswz(32 * vb + r32, ch));
                o = __builtin_amdgcn_mfma_f32_32x32x16_bf16(qf, rb, o, 0, 0, 0);
                if ((kk & 3) == 3) { asm volatile("" ::: "memory"); } }
#pragma nounroll
            for (int jb = 0; jb <= ib; ++jb) {
                f32x16 p = {};
                const int krow = L_K + (32 * jb + r32) * 512;
#pragma unroll
                for (int kk = 0; kk < 16; ++kk) { const int ch = 2 * kk + hi;
                    const bf16x8 kf = *(const LAS bf16x8*)(lds + krow + ((ch ^ rx) << 4)), qf = *(const LAS bf16x8*)(lds + qrow + ((ch ^ rx) << 4));
                    p = __builtin_amdgcn_mfma_f32_32x32x16_bf16(kf, qf, p, 0, 0, 0);
                    if ((kk & 3) == 3) { asm volatile("" ::: "memory"); } }
                { const int lim = (jb == ib ? r32 : 1024) - 4 * hi;
#pragma unroll
                  for (int r = 0; r < 16; ++r) p[r] = ((r & 3) + 8 * (r >> 2) > lim) ? 0.f : p[r] * rcd; }
                bf16x8 pa0, pa1; RET_PK4(p, 0, pa0); RET_PK4(p, 8, pa1);
                const bf16x8 v0 = *(const LAS bf16x8*)(lds + vrow + (((4 * jb + hi) ^ vx) << 4)), v1 = *(const LAS bf16x8*)(lds + vrow + (((4 * jb + 2 + hi) ^ vx) << 4));
                o = __builtin_amdgcn_mfma_f32_32x32x16_bf16(pa0, v0, o, 0, 0, 0); o = __builtin_amdgcn_mfma_f32_32x32x16_bf16(pa1, v1, o, 0, 0, 0);
                asm volatile("" ::: "memory");
            }
            { float lgn = lg2; asm volatile("" : "+v"(lgn));
              const float e0 = (float)(32 * ib + 4 * hi + 1) * lgn;
              char* ob = (char*)(O + (r0 + 32 * ib + 4 * hi) * RIN + h * RDV + vs * 128 + 32 * vb + r32);
#pragma unroll
              for (int r = 0; r < 16; ++r) { const int cr = (r & 3) + 8 * (r >> 2); const float qd = __builtin_amdgcn_exp2f(fmaf((float)cr, lgn, e0));
                  const float a = o[r] * qd, an = __shfl_xor(a, 1);
                  if ((r32 & 1) == 0) *(unsigned*)(ob + (size_t)cr * RIN * 2) = cvtpk(a, an); } }
            __syncthreads();
            bf16x8 kt[4];
            { typedef short s16x4 __attribute__((ext_vector_type(4)));
              const int l16 = lane & 15, q4 = l16 >> 2, p4 = l16 & 3, chunk = 4 * wid + 2 * ((lane >> 4) & 1) + (p4 >> 1);
#pragma unroll
              for (int h2 = 0; h2 < 2; ++h2) { const int rw = 8 * hi + 4 * h2 + q4; const int off = L_K + rw * 512 + ((chunk ^ rw) << 4) + (p4 & 1) * 8;
#pragma unroll
                  for (int sx = 0; sx < 4; ++sx) { const s16x4 t4 = __builtin_amdgcn_ds_read_tr16_b64_v4i16((LAS s16x4*)(lds + off + sx * 8192));
                      kt[sx][4 * h2 + 0] = t4[0]; kt[sx][4 * h2 + 1] = t4[1]; kt[sx][4 * h2 + 2] = t4[2]; kt[sx][4 * h2 + 3] = t4[3]; } } }
            if (n + 1 < NCH) RET_LOAD(n + 1);
#pragma unroll
            for (int q = 0; q < 4; ++q)
#pragma unroll
                for (int r = 0; r < 16; ++r) Racc[q][r] *= cd;
#pragma unroll
            for (int sx = 0; sx < 4; ++sx) {
#pragma unroll
                for (int q = 0; q < 4; ++q) { const bf16x8 vf = *(const LAS bf16x8*)(lds + L_V + (32 * q + r32) * 128 + (((2 * sx + hi) ^ vx) << 4));
                    Racc[q] = __builtin_amdgcn_mfma_f32_32x32x16_bf16(kt[sx], vf, Racc[q], 0, 0, 0); }
                asm volatile("" ::: "memory"); }
#pragma unroll
            for (int q = 0; q < 4; ++q)
#pragma unroll
                for (int g4 = 0; g4 < 4; ++g4) { const int v = 32 * q + r32; typedef unsigned u32x2 __attribute__((ext_vector_type(2)));
                    const u32x2 w = {cvtpk(Racc[q][4 * g4], Racc[q][4 * g4 + 1]), cvtpk(Racc[q][4 * g4 + 2], Racc[q][4 * g4 + 3])};
                    *(LAS u32x2*)(lds + rtswz(v, 4 * wid + g4) + 8 * hi) = w; }
            __syncthreads();
            if (n + 1 < NCH) { RET_PUT_QK(); RET_PUT_V(); __syncthreads(); }
        }
    }
#undef RET_LOAD
#undef RET_PUT_QK
#undef RET_PUT_V
}
#undef RET_PK4
}
#define RETCORE(raw, kt, vt, o) ret::core_mfma(cx, raw, kt, vt, o)
#define ATTN(mode, q, k, v, o, sm) att::attn_mfma<mode>(cx, q, k, v, o, sm)
#define ATTN_WIN_COMBINE(q, k, v, o, sm, oc, os, gt) att::attn_mfma<2>(cx, q, k, v, o, sm, oc, os, gt)
#else
#define ATTN(mode, q, k, v, o, sm) stage_attn(cx, mode, q, k, v, o, sm)
#define ATTN_WIN_COMBINE(q, k, v, o, sm, oc, os, gt) do { stage_attn(cx, 2, q, k, v, o, sm); stage_nsa_combine_host(cx, o, oc, os, gt); } while (0)
#define RETCORE(raw, kt, vt, o) stage_ret_core(cx, raw, kt, vt, o)
#define S5CORE(u, y, ab, bb, cre, cim, dsk) stage_s5_core(cx, u, y, ab, bb, cre, cim, dsk)
#endif

constexpr int PH_PER_LAYER = 20, N_PHASES = DEPTH * PH_PER_LAYER;
HD bool phase_exists(int ph) {
    const int layer = ph / PH_PER_LAYER, k = ph % PH_PER_LAYER, mx = layer % 3; const bool moe = (layer % 2) == 1;
    if (k == 0) return true;
    if (k >= 1 && k <= 9) { if (mx == 0) return k == 1 || (k >= 4 && k <= 6); if (mx == 1) return k != 8; return k == 1 || k == 3 || k == 4; }
    if (k == 10 || k == 11 || k == 12) return true;
    if (k == 13) return moe;
    if (k == 14 || k == 16) return true;
    return false;
}
#ifdef HOST_SIM
#define GRID_BAR() ((void)0)
#endif
#ifndef PHMASK
#define PHMASK 0xFFFFFFu
#endif
#ifndef MXMASK
#define MXMASK 7
#endif
#ifndef FFMASK
#define FFMASK 3
#endif
#define MX_ON(i) ((MXMASK >> (i)) & 1)
#define FF_ON(i) ((FFMASK >> (i)) & 1)
#ifdef HOST_SIM
#define FRESH_CTX() const Ctx& cx = cx0
#else
#define FRESH_CTX() Ctx cx = cx0; { unsigned l_ = (unsigned)(unsigned long long)cx.lds; unsigned long long w_ = (unsigned long long)cx.ws; int wv_ = cx0.wave; asm volatile("" : "+s"(wv_), "+s"(l_), "+s"(w_), "+s"(cx.bid), "+s"(cx.nblk)); \
    int ln_; asm volatile("v_mbcnt_lo_u32_b32 %0, -1, 0\n\tv_mbcnt_hi_u32_b32 %0, -1, %0" : "=v"(ln_)); \
    cx.lds = (LAS unsigned char*)l_; cx.ws = (unsigned char*)(__attribute__((address_space(1))) unsigned char*)w_; cx.lane = ln_; cx.wave = wv_; cx.tid = wv_ * 64 + ln_; }
#endif
#ifdef HOST_SIM
#define OPAQUE_S(x) ((void)0)
#else
#define OPAQUE_S(x) asm volatile("" : "+s"(x))
#endif
#ifndef DIAG
#define DIAG 0
#endif
HD bool diag_rep(int k, int mx, bool moe) {
    if (DIAG == 1) return k == 0;
    if (DIAG == 2) return (k == 1) || (mx == 1 && k == 3) || (!moe && k == 11) || (moe && (k == 12 || k == 13));
    if (DIAG == 3) return (mx == 0 && (k == 4)) || (mx == 1 && (k == 2 || k == 4 || k == 5 || k == 6 || k == 7)) || (mx == 2 && k == 3);
    if (DIAG == 4) return !moe && (k == 10 || k == 14);
    if (DIAG == 5) return mx == 0 && k == 4;
    if (DIAG == 6) return mx == 1 && (k == 2 || k == 4);
    if (DIAG == 7) return mx == 1 && (k == 5 || k == 6 || k == 7);
    if (DIAG == 8) return mx == 2 && k == 3;
    if (DIAG == 11) return mx == 0 && k == 1;
    if (DIAG == 12) return moe && k == 12;
    if (DIAG == 13) return moe && k == 13;
    if (DIAG == 14) return !moe && k == 11;
    if (DIAG == 19) return mx == 1 && k == 6;
    if (DIAG == 20) return mx == 1 && k == 7;
    if (DIAG == 21) return mx == 1 && k == 5;
    if (DIAG == 16) return mx == 1 && k == 4;
    if (DIAG == 17) return mx == 1 && k == 2;
    return false;
}
#if DIAG
#define PHASE_S(k, ...) do { int _id = base + (k); OPAQUE_S(_id); if (((PHMASK >> (k)) & 1u) && lo <= _id && _id < hi) { int nrep_ = (DIAG == 10) ? 3 : 1; OPAQUE_S(nrep_); \
    for (int rep_ = 0; rep_ < nrep_; ++rep_) { { FRESH_CTX(); const float SG = rep_ == 2 ? -1.0f : 1.0f; __VA_ARGS__; } if (rep_ + 1 < nrep_) { GRID_BAR(); } } if (_id + 1 < hi) { GRID_BAR(); } } } while (0)
#define PHASE(k, ...) do { int _id = base + (k); OPAQUE_S(_id); if (((PHMASK >> (k)) & 1u) && lo <= _id && _id < hi) { int nrep_ = diag_rep((k), mx, moe) ? 2 : 1; OPAQUE_S(nrep_); \
    for (int rep_ = 0; rep_ < nrep_; ++rep_) { { FRESH_CTX(); __VA_ARGS__; } if (rep_ + 1 < nrep_) { GRID_BAR(); } } if (_id + 1 < hi) { GRID_BAR(); } } } while (0)
#else
#define PHASE_S(k, ...) do { int _id = base + (k); OPAQUE_S(_id); if (((PHMASK >> (k)) & 1u) && lo <= _id && _id < hi) { { FRESH_CTX(); const float SG = 1.0f; __VA_ARGS__; } if (_id + 1 < hi) { GRID_BAR(); } } } while (0)
#define PHASE(k, ...) do { int _id = base + (k); OPAQUE_S(_id); if (((PHMASK >> (k)) & 1u) && lo <= _id && _id < hi) { { FRESH_CTX(); __VA_ARGS__; } if (_id + 1 < hi) { GRID_BAR(); } } } while (0)
#endif

#ifdef HOST_SIM
inline void program(const Ctx& cx0, const Args& args)
#else
#define XB_TMO      128
#define XB_XCNT(j)  (256  + 64 * (j))
#define XB_XSUB(j)  (1280 + 64 * (j))
#define XB_XGEN(j)  (2304 + 64 * (j))
#define XB_TOP      3328
#define XB_TOPGEN   3392
#define XCD_BAR_WORDS 3456
#define XB_SPIN_CAP (1u << 22)
__device__ __forceinline__ unsigned xb_ld(unsigned* p)              { return __hip_atomic_load(p, __ATOMIC_RELAXED, __HIP_MEMORY_SCOPE_AGENT); }
__device__ __forceinline__ unsigned xb_add(unsigned* p, unsigned v) { return __hip_atomic_fetch_add(p, v, __ATOMIC_RELAXED, __HIP_MEMORY_SCOPE_AGENT); }
__device__ __forceinline__ unsigned xb_xcc_id() { return (unsigned)__builtin_amdgcn_s_getreg((3 << 11) | 20) & 0xFu; }
#define XB_SPIN(cond, bar) do { unsigned _sp = 0; while (cond) { __builtin_amdgcn_s_sleep(1); \
    if ((++_sp & 255u) == 0u) { if (xb_ld(&(bar)[XB_TMO])) break; if (_sp > XB_SPIN_CAP) { atomicAdd(&(bar)[XB_TMO], 1u); break; } } } } while (0)
struct XcdBarrier { unsigned* bar; unsigned x; volatile LAS unsigned* st; };
__device__ __forceinline__ XcdBarrier xcd_barrier_post(unsigned* bar, volatile LAS unsigned* st, bool leader) {
    XcdBarrier b; b.bar = bar; b.x = xb_xcc_id(); b.st = st;
    if (leader) (void)xb_add(&bar[XB_XCNT(b.x)], 1u);
    return b;
}
__device__ __forceinline__ void xcd_barrier_complete(unsigned* bar, unsigned x, unsigned& nloc, unsigned& nx) {
    const unsigned G = gridDim.x * gridDim.y * gridDim.z;
    unsigned sum, cnt, mine, sp = 0u;
    for (;;) {
        sum = 0u; cnt = 0u; mine = 0u;
#pragma unroll
        for (unsigned j = 0; j < 16; ++j) { const unsigned c = xb_ld(&bar[XB_XCNT(j)]); sum += c; cnt += (c > 0u) ? 1u : 0u; mine = (j == x) ? c : mine; }
        if (sum == G) break;
        __builtin_amdgcn_s_sleep(1);
        if ((++sp & 255u) == 0u) { if (xb_ld(&bar[XB_TMO])) break; if (sp > XB_SPIN_CAP) { atomicAdd(&bar[XB_TMO], 1u); break; } }
    }
    nloc = mine > 0u ? mine : 1u; nx = cnt > 0u ? cnt : 1u;
}
__device__ __forceinline__ void xcd_barrier(const XcdBarrier& b, bool leader) {
    asm volatile("s_waitcnt vmcnt(0)" ::: "memory");
    __syncthreads();
    if (leader) {
        unsigned* bar = b.bar;
        __builtin_amdgcn_s_waitcnt(0);
        unsigned nloc = b.st[0], nx = b.st[1];
        if (nloc == 0u) { xcd_barrier_complete(bar, b.x, nloc, nx); b.st[0] = nloc; b.st[1] = nx; }
        const unsigned old = xb_add(&bar[XB_XSUB(b.x)], 1u);
        const unsigned gen = old / nloc;
        if (old + 1u == (gen + 1u) * nloc) {
            __builtin_amdgcn_fence(__ATOMIC_RELEASE, "agent");
            asm volatile("s_waitcnt vmcnt(0)" ::: "memory");
            const unsigned og = xb_add(&bar[XB_TOP], 1u);
            const unsigned tg = og / nx;
            if (og + 1u == (tg + 1u) * nx) xb_add(&bar[XB_TOPGEN], 1u);
            else XB_SPIN(xb_ld(&bar[XB_TOPGEN]) == tg, bar);
            __builtin_amdgcn_fence(__ATOMIC_ACQUIRE, "agent");
            xb_add(&bar[XB_XGEN(b.x)], 1u);
            asm volatile("s_waitcnt vmcnt(0)" ::: "memory");
        } else {
            XB_SPIN(xb_ld(&bar[XB_XGEN(b.x)]) == gen, bar);
            __builtin_amdgcn_fence(__ATOMIC_ACQUIRE, "agent");
            asm volatile("s_waitcnt vmcnt(0)" ::: "memory");
        }
    }
    __syncthreads();
}
#define GRID_BAR() do { int ln_; asm volatile("v_mbcnt_lo_u32_b32 %0, -1, 0\n\tv_mbcnt_hi_u32_b32 %0, -1, %0" : "=v"(ln_)); xcd_barrier(bar, cx0.wave == 0 && ln_ == 0); } while (0)
__global__ void __launch_bounds__(NT, 2) trunk_fwd(Args args)
#endif
{
#ifndef HOST_SIM
    extern __shared__ __attribute__((aligned(16))) unsigned char lds_raw[];
    Ctx cx0; cx0.lds = (LAS unsigned char*)lds_raw; cx0.tid = threadIdx.x; cx0.lane = cx0.tid & 63; { int w0_ = __builtin_amdgcn_readfirstlane(cx0.tid >> 6); asm volatile("" : "+s"(w0_)); cx0.wave = w0_; } cx0.bid = blockIdx.x; cx0.nblk = gridDim.x; cx0.ws = args.ws;
    volatile LAS unsigned* misc = (volatile LAS unsigned*)(cx0.lds + LDS_MISC);
    if (cx0.tid < 32) misc[cx0.tid] = 0u;
    if (cx0.tid == 0) { LAS unsigned long long* tab = (LAS unsigned long long*)(cx0.lds + LDS_TAB);
#pragma unroll
        for (int i = 0; i < N_INPUTS; ++i) tab[i] = (unsigned long long)args.in[i];
        tab[N_INPUTS] = (unsigned long long)args.out; }
    __syncthreads();
    XcdBarrier bar = xcd_barrier_post((unsigned*)(args.ws + OFF_CTL) + CW_BAR, misc + 8, cx0.tid == 0);
#endif
    const int lo = args.ph_lo, hi = args.ph_hi;
#define WSP(type, off) ((type*)(cx.ws + (off)))
#define Hm WSP(bf16, OFF_H + (size_t)(layer & 1) * T * D * 2)
#define Hn WSP(bf16, OFF_H + (size_t)((layer & 1) ^ 1) * T * D * 2)
#define RINV WSP(float, OFF_RINV)
#define SSQB WSP(float, OFF_SSQ)
#define XN WSP(bf16, OFF_XN)
#define PB WSP(bf16, OFF_PB)
#define PROJ WSP(bf16, OFF_PROJ)
#define TOPI WSP(int, OFF_TOPI)
#define TOPW WSP(float, OFF_TOPW)
#define SLOT WSP(int, OFF_SLOT)
#define ROWS WSP(int, OFF_ROWS)
#define CMPB WSP(float, OFF_CMPB)
#define S5AB WSP(float, OFF_S5AB)
#define S5BB WSP(float, OFF_S5BB)
#define SELM WSP(unsigned, OFF_SELM)
#define GT WSP(float, OFF_GT)
#define SCRP(type, off) WSP(type, OFF_SCR + (off))
#define RAW_R SCRP(bf16, SC_RET_RAW)
#define O_R (RAW_R + 2 * RH * RDK)
#define KT_R SCRP(bf16, SC_RET_KT)
#define VT_R SCRP(bf16, SC_RET_VT)
#define RAW_N SCRP(bf16, SC_N_RAW)
#define QN SCRP(bf16, SC_N_QN)
#define KS SCRP(bf16, SC_N_KS)
#define VS SCRP(bf16, SC_N_VS)
#define KW SCRP(bf16, SC_N_KW)
#define VW SCRP(bf16, SC_N_VW)
#define KCR SCRP(bf16, SC_N_KCR)
#define VCR SCRP(bf16, SC_N_VCR)
#define HID SCRP(bf16, SC_N_HID)
#define KC SCRP(bf16, SC_N_KC)
#define VC SCRP(bf16, SC_N_VC)
#define OC SCRP(bf16, SC_N_OC)
#define OS SCRP(bf16, SC_N_OS)
#define OW SCRP(bf16, SC_N_OW)
#define U_S SCRP(bf16, SC_S5_U)
#define Y_S SCRP(bf16, SC_S5_Y)
#define ACT_F SCRP(bf16, SC_FFN_ACT)
#define ACT_M SCRP(bf16, SC_MOE_ACT)
#define Y_M SCRP(bf16, SC_MOE_Y)
#define POS ((const int*)IN(I_POS))
#define CNT (WSP(int, OFF_CTL) + CW_MOE + fj * 64)
#define CNT2 (CNT + 16)

#pragma nounroll
    for (int layer = 0; layer < DEPTH; ++layer) {
        const int base = layer * PH_PER_LAYER, mx = layer % 3, mj = layer / 3, fj = layer / 2; const bool moe = (layer % 2) == 1;
        PHASE(0, {
            if (mx == 0) { prep_transpose(cx, IN(I_RWIN) + (size_t)mj * D * RIN, D, RIN, WSP(bf16, OFF_W_RIN), RIN, 0, 0, 0.f, IN(I_NMIX) + (size_t)layer * D);
                           prep_transpose(cx, IN(I_RWOUT) + (size_t)mj * RVW * D, RVW, D, WSP(bf16, OFF_W_ROUT), D, 0, 0); }
            else if (mx == 1) { prep_transpose(cx, IN(I_NWIN) + (size_t)mj * D * NSA_IN, D, NSA_IN, WSP(bf16, OFF_W_NIN), NSA_INP, 0, 0, 0.f, IN(I_NMIX) + (size_t)layer * D);
                           for (int kv = 0; kv < 2; ++kv) prep_transpose(cx, IN(I_NCW1) + ((size_t)mj * 2 + kv) * CK * CHID, CK, CHID, WSP(bf16, OFF_W_CMP) + (size_t)kv * CHID * CK, CHID, 0, 0);
                           prep_transpose(cx, IN(I_NWOUT) + (size_t)mj * D * D, D, D, WSP(bf16, OFF_W_NOUT), D, 0, 0);
                           stage_cmp_bias_part(cx, IN(I_NCPOS) + (size_t)mj * 2 * CK, IN(I_NCW1) + (size_t)mj * 2 * CK * CHID, (float*)HID  ); PREP_W2T(IN(I_NCW2) + (size_t)mj * 2 * CHID * NDH, WSP(bf16, OFF_W_CMP2)); }
            else { prep_transpose(cx, IN(I_SWIN) + (size_t)mj * D * D, D, D, WSP(bf16, OFF_W_SIN), D, 0, 0, 0.f, IN(I_NMIX) + (size_t)layer * D);
                   prep_transpose(cx, IN(I_SWGLU) + (size_t)mj * D * 2 * D, D, 2 * D, WSP(bf16, OFF_W_SGLU), 2 * D, 1, D);
                   stage_s5_prep(cx, IN(I_SARE) + (size_t)mj * SG * SP, IN(I_SAIM) + (size_t)mj * SG * SP, IN(I_SBRE) + (size_t)mj * SG * SP * SGC, IN(I_SBIM) + (size_t)mj * SG * SP * SGC,
                                 IN(I_SLDT) + (size_t)mj * SG, S5AB, S5BB); }
            if (!moe) { if ((GU8_MASK >> layer) & 1u) prep_transpose(cx, IN(I_FWGU) + (size_t)fj * D * 2 * DFF, D, 2 * DFF, WSP(bf16, OFF_W_FGU), 2 * DFF, 1, DFF, F8S_WGU);
                        else prep_transpose(cx, IN(I_FWGU) + (size_t)fj * D * 2 * DFF, D, 2 * DFF, WSP(bf16, OFF_W_FGU), 2 * DFF, 1, DFF, 0.f, IN(I_NFFN) + (size_t)layer * D);
                        prep_transpose(cx, IN(I_FWDN) + (size_t)fj * DFF * D, DFF, D, WSP(bf16, OFF_W_FDN), D, 0, 0, ((DN8_MASK >> layer) & 1u) ? F8S_WDN : 0.f); }
            else { prep_transpose_multi(cx, IN(I_MWGU) + (size_t)fj * NE * D * 2 * DFE, (size_t)D * 2 * DFE, NE, D, 2 * DFE, WSP(bf16, OFF_W_MGU), (size_t)2 * DFE * D, 2 * DFE, 1, DFE, F8S_WGU);
                   prep_transpose_multi(cx, IN(I_MWDN) + (size_t)fj * NE * DFE * D, (size_t)DFE * D, NE, DFE, D, WSP(bf16, OFF_W_MDN), (size_t)D * DFE, D, 0, 0, F8S_WDN); }
            prep_transpose(cx, IN(I_PWPROJ) + (size_t)layer * PLE * D, PLE, D, WSP(bf16, OFF_W_PPROJ), D, 0, 0);
            prep_transpose(cx, IN(I_PWGATE) + (size_t)layer * D * D, D, D, WSP(bf16, OFF_W_PGATE), D, 0, 0, 0.f, IN(I_NPLE) + (size_t)layer * D);
            if (layer == 0) stage_norm(cx, IN(I_X), Hm, Hm, IN(I_NMIX) + (size_t)layer * D, nullptr, nullptr, nullptr, nullptr, nullptr, nullptr, nullptr, nullptr, RINV);
            else stage_rinv(cx, SSQB, D / BN * 4, RINV);
            stage_p2b(cx, IN(I_P) + (size_t)layer * T * PLE, PB);
        });
        if (DIAG == 9) { for (int xb_ = 0; xb_ < 10; ++xb_) { GRID_BAR(); } }
        if (MX_ON(0) && mx == 0) {

            PHASE(1, { SchedDense sc{Hm, (const bf16*)WSP(bf16, OFF_W_RIN), D, D, T / BMR, RIN / BN, cx.nblk, cx.bid}; gemm_run(cx, D, D, D, sc, ERetIn{RAW_R, KT_R, VT_R, POS, RINV}); });
            PHASE(4, { RETCORE(RAW_R, KT_R, VT_R, O_R); });
            PHASE(5, { stage_ret_norm(cx, O_R, RAW_R, IN(I_RGN) + (size_t)mj * RVW, VT_R); });
            PHASE_S(6, { SchedDense sc{VT_R, (const bf16*)WSP(bf16, OFF_W_ROUT), RVW, RVW, T / BMR, D / BN, cx.nblk, cx.bid}; gemm_run(cx, RVW, RVW, RVW, sc, EResAdd{Hm, SG, SSQB}); });
        } else if (MX_ON(1) && mx == 1) {


            PHASE(1, { SchedDense sc{Hm, (const bf16*)WSP(bf16, OFF_W_NIN), D, D, T / BMR, NSA_INP / BN, cx.nblk, cx.bid}; gemm_run(cx, D, D, D, sc, EStoreBf16R{RAW_N, NSA_INP, RINV}); });
            PHASE(2, { NSAPREP1(RAW_N, POS, IN(I_NQN) + (size_t)mj * NDH, IN(I_NKN) + (size_t)mj * 3 * NDH, QN, KS, VS, KW, VW, KCR, VCR, GT);
                       stage_transpose_cols2(cx, RAW_N, NSA_INP, D + 3 * KVW, D + 5 * KVW, KVW, VS, VW); stage_cmp_bias_red(cx, (const float*)HID, CMPB); });
            PHASE(3, { SchedCmp sc{KCR, VCR, (const bf16*)WSP(bf16, OFF_W_CMP), cx.nblk, cx.bid}; gemm_run(cx, CLDA, CK, CK, sc, ECmp{HID, CMPB}); });
            PHASE(4, { CMP2(HID, IN(I_NCW2) + (size_t)mj * 2 * CHID * NDH, (const bf16*)WSP(bf16, OFF_W_CMP2), IN(I_NKN) + (size_t)mj * 3 * NDH, POS, KC, VC); });
            PHASE(5, { ATTN(0, QN, KC, VC, OC, SELM); });
            PHASE(6, { ATTN(1, QN, KS, VS, OS, SELM); });
            PHASE(7, { ATTN_WIN_COMBINE(QN, KW, VW, OW, SELM, OC, OS, GT); });
            PHASE_S(9, { SchedDense sc{OW, (const bf16*)WSP(bf16, OFF_W_NOUT), D, D, T / BMR, D / BN, cx.nblk, cx.bid}; gemm_run(cx, D, D, D, sc, EResAdd{Hm, SG, SSQB}); });
        } else if (MX_ON(2) && mx == 2) {

            PHASE(1, { SchedDense sc{Hm, (const bf16*)WSP(bf16, OFF_W_SIN), D, D, T / BMR, D / BN, cx.nblk, cx.bid}; gemm_run(cx, D, D, D, sc, EStoreBf16R{U_S, D, RINV}); });
            PHASE(3, { S5CORE(U_S, Y_S, S5AB, S5BB, IN(I_SCRE) + (size_t)mj * SG * SGC * SP, IN(I_SCIM) + (size_t)mj * SG * SGC * SP, IN(I_SD) + (size_t)mj * D); });
            PHASE_S(4, { SchedDense sc{Y_S, (const bf16*)WSP(bf16, OFF_W_SGLU), D, D, T / BMR, 2 * D / BN, cx.nblk, cx.bid}; gemm_run(cx, D, D, D, sc, EGlu{Hm, SG, SSQB}); });
        }
#define PLE_PROJ() do { SchedDense scp{PB, (const bf16*)WSP(bf16, OFF_W_PPROJ), PLE, PLE, T / BMR, D / BN, cx.nblk, cx.bid}; gemm_run(cx, PLE, PLE, PLE, scp, EStoreBf16{PROJ, D}); } while (0)
        if (FF_ON(0) && !moe) {

            const bool gu8 = ((GU8_MASK >> layer) & 1u) != 0u;
            PHASE(10, { if (gu8) stage_norm(cx, nullptr, Hm, nullptr, IN(I_NFFN) + (size_t)layer * D, nullptr, nullptr, nullptr, nullptr, nullptr, nullptr, nullptr, nullptr, nullptr, (fp8*)XN);
                        else stage_rinv(cx, SSQB, mx == 2 ? D / IB * 4 : D / BN * 4, RINV); });
            const bool dn8 = ((DN8_MASK >> layer) & 1u) != 0u;
            PHASE(11, { if (gu8) { SchedDense sc8{XN, (const bf16*)WSP(bf16, OFF_W_FGU), D / 2, D / 2, T / BMR, 2 * DFF / BN, cx.nblk, cx.bid}; gemm_run<true>(cx, D, D, D, sc8, ESwiGLU8{(fp8*)ACT_F, DFF, 1.0f / (F8S_X * F8S_WGU)}); }
                        else { SchedDense sc{Hm, (const bf16*)WSP(bf16, OFF_W_FGU), D, D, T / BMR, 2 * DFF / BN, cx.nblk, cx.bid};
                        if (dn8) gemm_run(cx, D, D, D, sc, ESwiGLU8R{(fp8*)ACT_F, DFF, RINV}); else gemm_run(cx, D, D, D, sc, ESwiGLU{ACT_F, DFF, RINV}); } });
            PHASE_S(12, { if (dn8) { SchedDense sc{ACT_F, (const bf16*)WSP(bf16, OFF_W_FDN), DFF / 2, DFF / 2, T / BMR, D / BN, cx.nblk, cx.bid};
                              gemm_run<true>(cx, DFF, DFF, DFF, sc, EResAdd{Hm, SG * (1.0f / (F8S_ACT * F8S_WDN)), SSQB}); }
                          else { SchedDense sc{ACT_F, (const bf16*)WSP(bf16, OFF_W_FDN), DFF, DFF, T / BMR, D / BN, cx.nblk, cx.bid}; gemm_run(cx, DFF, DFF, DFF, sc, EResAdd{Hm, SG, SSQB}); } });
            PHASE(14, { stage_rinv(cx, SSQB, D / BN * 4, RINV); PLE_PROJ(); });
        } else if (FF_ON(1) && moe) {

            PHASE(10, { stage_norm(cx, nullptr, Hm, nullptr, IN(I_NFFN) + (size_t)layer * D, nullptr, nullptr, nullptr, nullptr, IN(I_MROUTER) + (size_t)fj * D * NE, TOPI, TOPW, CNT, nullptr, (fp8*)XN); });
            PHASE(11, { stage_moe_assign(cx, TOPI, SLOT, (const fp8*)XN, Y_M, CNT, CNT2); });
            PHASE(12, { SchedMoE<false> sc; sc.A = Y_M; sc.W = (const bf16*)WSP(bf16, OFF_W_MGU); sc.rows = nullptr; sc.lda = D / 2; sc.wstride = 2 * DFE * D / 2; sc.ldb = D / 2; sc.nN = 2 * DFE / BN; sc.G = cx.nblk; sc.c = cx.bid; sc.init(CNT);
                               gemm_run<true>(cx, D, D, D, sc, ESwiGLU8{(fp8*)ACT_M, DFE, 1.0f / (F8S_X * F8S_WGU)}); });
            PHASE(13, { SchedMoE<false> sc; sc.A = ACT_M; sc.W = (const bf16*)WSP(bf16, OFF_W_MDN); sc.rows = nullptr; sc.lda = DFE / 2; sc.wstride = D * DFE / 2; sc.ldb = DFE / 2; sc.nN = D / BN; sc.G = cx.nblk; sc.c = cx.bid; sc.init(CNT);
                               gemm_run<true>(cx, DFE, DFE, DFE, sc, EStoreBf16S{Y_M, D, 1.0f / (F8S_ACT * F8S_WDN)});
                               { const int w0 = (sc.tl[NE] * sc.nN) % cx.nblk; const bool restr = w0 > 0 && w0 <= cx.nblk / 2;
                                 SchedDense scp{PB, (const bf16*)WSP(bf16, OFF_W_PPROJ), PLE, PLE, T / BMR, D / BN, restr ? cx.nblk - w0 : cx.nblk, restr ? cx.bid - w0 : cx.bid}; gemm_run(cx, PLE, PLE, PLE, scp, EStoreBf16{PROJ, D}); } });
            PHASE(14, { stage_norm(cx, nullptr, Hm, Hm, IN(I_NPLE) + (size_t)layer * D, nullptr, Y_M, SLOT, TOPW, nullptr, nullptr, nullptr, nullptr, RINV); });
        }
        PHASE_S(16, { SchedDense sc{Hm, (const bf16*)WSP(bf16, OFF_W_PGATE), D, D, T / BMR, D / BN, cx.nblk, cx.bid}; gemm_run(cx, D, D, D, sc, EPle{Hm, (layer == DEPTH - 1) ? (bf16*)nullptr : Hn, (layer == DEPTH - 1) ? OUTP : (float*)nullptr, PROJ, SG, RINV, SSQB});
            if (DIAG == 10 && layer == DEPTH - 1 && SG < 0.f) { GRID_BAR(); gemm_run(cx, D, D, D, sc, EPle{Hm, nullptr, OUTP, PROJ, 0.0f, RINV, SSQB}); } });
    }
}

#ifndef HOST_SIM
#ifndef ONE_LAUNCH
#define ONE_LAUNCH 1
#endif
extern "C" void kernel_launch(void* const* d_in, const int* in_sizes, int n_in, void* d_out, int out_size, void* d_ws, size_t ws_size, hipStream_t stream) {
    static int grid = 0;
    if (grid == 0) {
        if (n_in != N_INPUTS || out_size != T * D || ws_size < WS_NEED) { fprintf(stderr, "kernel_launch: shape/workspace mismatch (n_in %d out %d ws %zu need %zu)\n", n_in, out_size, ws_size, (size_t)WS_NEED); grid = -1; return; }
        int dev = 0, cus = 0, per_cu = 0;
        if (hipGetDevice(&dev) != hipSuccess || hipDeviceGetAttribute(&cus, hipDeviceAttributeMultiprocessorCount, dev) != hipSuccess) { grid = -1; return; }
        if (hipFuncSetAttribute((const void*)trunk_fwd, hipFuncAttributeMaxDynamicSharedMemorySize, LDS_BYTES) != hipSuccess) { fprintf(stderr, "kernel_launch: hipFuncSetAttribute failed\n"); grid = -1; return; }
        if (hipOccupancyMaxActiveBlocksPerMultiprocessor(&per_cu, (const void*)trunk_fwd, NT, LDS_BYTES) != hipSuccess || per_cu < 1) fprintf(stderr, "kernel_launch: occupancy query says %d\n", per_cu);
        (void)hipGetLastError();
        grid = cus;
    }
    if (grid < 0) return;
    (void)hipMemsetAsync((char*)d_ws + OFF_CTL, 0, CTL_BYTES, stream);
    Args a{};
    for (int i = 0; i < N_INPUTS; ++i) a.in[i] = (const float*)d_in[i];
    a.out = (float*)d_out; a.ws = (unsigned char*)d_ws;
#if ONE_LAUNCH
    a.ph_lo = 0; a.ph_hi = N_PHASES;
    hipLaunchKernelGGL(trunk_fwd, dim3(grid), dim3(NT), LDS_BYTES, stream, a);
#else
    for (int ph = 0; ph < N_PHASES; ++ph) { if (!phase_exists(ph)) continue; a.ph_lo = ph; a.ph_hi = ph + 1; hipLaunchKernelGGL(trunk_fwd, dim3(grid), dim3(NT), LDS_BYTES, stream, a); }
#endif
}
#endif
```
